# Optimizing an MI355X kernel written in HIP

```python
import math
import jax
import jax.numpy as jnp
from jax import lax
import numpy as np

D_MODEL = 1024
BATCH = 4
SEQ = 8192
DEPTH = 4

MIX_WIDTH = D_MODEL
SSD_HEADS = 8
SSD_HEAD_DIM = 64
SSD_INNER = SSD_HEADS * SSD_HEAD_DIM
SSD_GROUPS = 2
SSD_STATE = 128
SSD_CONV = 4
SSD_CHUNK = 256
SSD_XBC = SSD_INNER + 2 * SSD_GROUPS * SSD_STATE
SC_HEADS = 4
SC_HEAD_DIM = 64
SC_WIDTH = SC_HEADS * SC_HEAD_DIM
SC_CONV = 3
NSA_HEADS = 4
NSA_HEAD_DIM = 64
NSA_WIDTH = NSA_HEADS * NSA_HEAD_DIM
NSA_KV = NSA_HEAD_DIM
CMP_BLOCK = 32
CMP_STRIDE = 16
CMP_HIDDEN = 128
SEL_BLOCK = 64
SEL_TOPK = 16
SEL_LOCAL = 2
WINDOW = 512
Q_BLOCK = 128
ROPE_THETA = 10000.0
D_FF = 2752
FFN_CONV = 3
EPS = 1e-6
NEG = -1e30
FORCE = 1e9
IN_SIZES = (SSD_INNER, SSD_XBC, SSD_HEADS, SC_WIDTH, SC_WIDTH, SC_WIDTH, NSA_WIDTH,
            NSA_KV, NSA_KV, NSA_KV, NSA_KV, NSA_KV, NSA_KV, 3 * NSA_HEADS)
N_IN = sum(IN_SIZES)

kernel_name = 'hymba_ssd_shortconv_nsa_trunk'


def rmsnorm(x, w):
    xf = x.astype(jnp.float32)
    y = xf * lax.rsqrt(jnp.mean(xf * xf, axis=-1, keepdims=True) + EPS)
    return (y * w.astype(jnp.float32)).astype(x.dtype)


def causal_dwconv(u, w, b=None):
    width = w.shape[0]
    s_len = u.shape[1]
    up = jnp.pad(u, ((0, 0), (width - 1, 0), (0, 0)))
    out = up[:, 0:s_len] * w[0]
    for j in range(1, width):
        out = out + up[:, j:j + s_len] * w[j]
    if b is not None:
        out = out + b
    return out


def rope_tables(s_len):
    half = NSA_HEAD_DIM // 2
    inv = 1.0 / (ROPE_THETA ** (jnp.arange(half, dtype=jnp.float32) / half))
    ang = jnp.arange(s_len, dtype=jnp.float32)[:, None] * inv[None, :]
    return jnp.cos(ang), jnp.sin(ang)


def apply_rope(x, cos, sin):
    x1, x2 = jnp.split(x, 2, axis=-1)
    c = cos[None, :, None, :].astype(x.dtype)
    s = sin[None, :, None, :].astype(x.dtype)
    return jnp.concatenate([x1 * c - x2 * s, x2 * c + x1 * s], axis=-1)


def masked_softmax(s, mask):
    s = jnp.where(mask, s.astype(jnp.float32), NEG)
    m = jnp.max(s, axis=-1, keepdims=True)
    p = jnp.exp(s - m) * mask
    return p / jnp.maximum(jnp.sum(p, axis=-1, keepdims=True), 1e-20)


def ssd_mixer(z, xbc, dt_raw, conv_w, conv_b, dt_bias, a_log, d_skip, norm_w):
    f32 = jnp.float32
    bsz, s_len, _ = z.shape
    n_k = SSD_HEADS // SSD_GROUPS
    xbc = jax.nn.silu(causal_dwconv(xbc, conv_w, conv_b))
    xs, b_in, c_in = jnp.split(xbc, [SSD_INNER, SSD_INNER + SSD_GROUPS * SSD_STATE], axis=-1)
    dt = jax.nn.softplus((dt_raw + dt_bias).astype(f32))
    a_neg = -jnp.exp(a_log.astype(f32)).reshape(SSD_GROUPS, n_k)
    pad = (-s_len) % SSD_CHUNK
    s_pad = s_len + pad
    n_c = s_pad // SSD_CHUNK

    def chunked(t, *tail):
        t = jnp.pad(t.astype(f32), ((0, 0), (0, pad), (0, 0)))
        return t.reshape(bsz, n_c, SSD_CHUNK, *tail)

    x_c = chunked(xs, SSD_GROUPS, n_k, SSD_HEAD_DIM)
    dt_c = chunked(dt, SSD_GROUPS, n_k)
    b_c = chunked(b_in, SSD_GROUPS, SSD_STATE)
    c_c = chunked(c_in, SSD_GROUPS, SSD_STATE)
    xdt = x_c * dt_c[..., None]
    a = jnp.transpose(dt_c * a_neg, (0, 3, 4, 1, 2))
    a_cs = jnp.cumsum(a, axis=-1)
    causal = jnp.tril(jnp.ones((SSD_CHUNK, SSD_CHUNK), dtype=bool))
    seg = a_cs[..., :, None] - a_cs[..., None, :]
    decay = jnp.exp(jnp.where(causal, seg, -jnp.inf))
    cb = jnp.einsum('bclgn,bcsgn->bgcls', c_c, b_c)
    y_diag = jnp.einsum('bgkcls,bcsgkp->bclgkp', decay * cb[:, :, None], xdt)
    decay_to_end = jnp.exp(a_cs[..., -1:] - a_cs)
    chunk_states = jnp.einsum('bclgn,bgkcl,bclgkp->cbgkpn', b_c, decay_to_end, xdt)
    chunk_decay = jnp.moveaxis(jnp.exp(a_cs[..., -1]), -1, 0)

    def step(h, inp):
        s_new, d_c = inp
        return h * d_c[..., None, None] + s_new, h

    h0 = jnp.zeros((bsz, SSD_GROUPS, n_k, SSD_HEAD_DIM, SSD_STATE), f32)
    _, prev_states = lax.scan(step, h0, (chunk_states, chunk_decay))
    y_off = jnp.einsum('bclgn,cbgkpn,bgkcl->bclgkp', c_c, prev_states, jnp.exp(a_cs))
    y = y_diag + y_off + x_c * d_skip.astype(f32).reshape(SSD_GROUPS, n_k)[:, :, None]
    y = y.reshape(bsz, s_pad, SSD_INNER)[:, :s_len]
    y = y * jax.nn.silu(z.astype(f32))
    return rmsnorm(y, norm_w).astype(z.dtype)


def compress_block(t, pos, w1, w2):
    bsz, s_len, dk = t.shape
    n_cmp = (s_len - CMP_BLOCK) // CMP_STRIDE + 1
    idx = np.arange(n_cmp)[:, None] * CMP_STRIDE + np.arange(CMP_BLOCK)[None, :]
    blocks = (t[:, idx] + pos).reshape(bsz, n_cmp, CMP_BLOCK * dk)
    return jax.nn.gelu(blocks @ w1) @ w2


def nsa_mixer(q, k_cmp, v_cmp, k_sel, v_sel, k_win, v_win, gate_logits, cos, sin,
              kpos, kw1, kw2, vpos, vw1, vw2):
    bsz, s_len, _ = q.shape
    dk = NSA_HEAD_DIM
    q = apply_rope(q.reshape(bsz, s_len, NSA_HEADS, dk), cos, sin) * (dk ** -0.5)

    def rope_k(t):
        return apply_rope(t[:, :, None, :], cos, sin)[:, :, 0, :]

    kc = compress_block(rope_k(k_cmp), kpos, kw1, kw2)
    vc = compress_block(v_cmp, vpos, vw1, vw2)
    n_cmp = kc.shape[1]
    n_slc = s_len // SEL_BLOCK
    top = min(SEL_TOPK, n_slc)
    cmp_start = np.arange(n_cmp) * CMP_STRIDE
    slc_start = np.arange(n_slc) * SEL_BLOCK
    cmp_end = jnp.asarray(cmp_start + CMP_BLOCK - 1, jnp.int32)
    overlap = jnp.asarray(((cmp_start[:, None] < slc_start[None, :] + SEL_BLOCK)
                           & (cmp_start[:, None] + CMP_BLOCK > slc_start[None, :])).astype(np.float32))
    ks_blocks = rope_k(k_sel).reshape(bsz, n_slc, SEL_BLOCK, dk)
    vs_blocks = v_sel.reshape(bsz, n_slc, SEL_BLOCK, dk)
    win_pad = ((0, 0), (WINDOW, 0), (0, 0))
    kw = jnp.pad(rope_k(k_win), win_pad)
    vw = jnp.pad(v_win, win_pad)
    gates = jax.nn.sigmoid(gate_logits.astype(jnp.float32)).reshape(bsz, s_len, NSA_HEADS, 3)
    n_qb = s_len // Q_BLOCK

    def to_blocks(t):
        return jnp.moveaxis(t.reshape(bsz, n_qb, Q_BLOCK, *t.shape[2:]), 1, 0)

    blk = jnp.arange(n_slc)
    offs = jnp.arange(SEL_BLOCK)
    gather = jax.vmap(lambda blocks, idx: blocks[idx])

    def block_fn(args):
        qb, gb, qi = args
        t = qi * Q_BLOCK + jnp.arange(Q_BLOCK)
        p_c = masked_softmax(jnp.einsum('bqhd,bnd->bhqn', qb, kc), cmp_end[None, :] <= t[:, None])
        o_c = jnp.einsum('bhqn,bnd->bqhd', p_c, vc)
        imp = jnp.einsum('bhqn,nj->bqj', p_c, overlap)
        cur = (t // SEL_BLOCK)[:, None]
        valid = blk[None, :] <= cur
        forced = (blk[None, :] == 0) | (valid & (blk[None, :] > cur - SEL_LOCAL))
        imp = jnp.where(forced, FORCE, jnp.where(valid, imp, NEG))
        _, sel = lax.top_k(imp, top)
        ks = gather(ks_blocks, sel).reshape(bsz, Q_BLOCK, top * SEL_BLOCK, dk)
        vs = gather(vs_blocks, sel).reshape(bsz, Q_BLOCK, top * SEL_BLOCK, dk)
        tok = (sel[..., None] * SEL_BLOCK + offs).reshape(bsz, Q_BLOCK, top * SEL_BLOCK)
        m_s = (tok <= t[None, :, None])[:, None]
        p_s = masked_softmax(jnp.einsum('bqhd,bqnd->bhqn', qb, ks), m_s)
        o_s = jnp.einsum('bhqn,bqnd->bqhd', p_s, vs)
        start = qi * Q_BLOCK
        kwb = lax.dynamic_slice_in_dim(kw, start, Q_BLOCK + WINDOW, axis=1)
        vwb = lax.dynamic_slice_in_dim(vw, start, Q_BLOCK + WINDOW, axis=1)
        kp = start - WINDOW + jnp.arange(Q_BLOCK + WINDOW)
        m_w = (kp[None, :] >= 0) & (kp[None, :] <= t[:, None]) & (kp[None, :] > t[:, None] - WINDOW)
        p_w = masked_softmax(jnp.einsum('bqhd,bkd->bhqk', qb, kwb), m_w)
        o_w = jnp.einsum('bhqk,bkd->bqhd', p_w, vwb)
        return o_c * gb[..., 0:1] + o_s * gb[..., 1:2] + o_w * gb[..., 2:3]

    out = lax.map(block_fn, (to_blocks(q), to_blocks(gates), jnp.arange(n_qb)))
    return jnp.moveaxis(out, 0, 1).reshape(bsz, s_len, NSA_WIDTH).astype(q.dtype)


def setup_inputs(seed: int = 0) -> dict:
    key = jax.random.key(seed)
    ks = jax.random.split(key, 24)
    f32 = jnp.float32
    nl = DEPTH
    cmp_in = CMP_BLOCK * NSA_HEAD_DIM

    def nrm(k, shape, scale):
        return jax.random.normal(k, shape, f32) * scale

    dt0 = jnp.exp(jax.random.uniform(ks[5], (nl, SSD_HEADS), f32, math.log(1e-3), math.log(1e-1)))
    return {
        'x': nrm(ks[0], (BATCH, SEQ, D_MODEL), 1.0),
        'attn_norm_w': 1.0 + nrm(ks[1], (nl, D_MODEL), 0.02),
        'w_in': nrm(ks[2], (nl, D_MODEL, N_IN), D_MODEL ** -0.5),
        'ssd_conv_w': nrm(ks[3], (nl, SSD_CONV, SSD_XBC), SSD_CONV ** -0.5),
        'ssd_conv_b': nrm(ks[4], (nl, SSD_XBC), 0.02),
        'ssd_dt_bias': dt0 + jnp.log(-jnp.expm1(-dt0)),
        'ssd_a_log': jnp.log(jax.random.uniform(ks[6], (nl, SSD_HEADS), f32, 1.0, 16.0)),
        'ssd_d': 1.0 + nrm(ks[7], (nl, SSD_HEADS), 0.02),
        'ssd_norm_w': 1.0 + nrm(ks[8], (nl, SSD_INNER), 0.02),
        'sc_conv_w': nrm(ks[9], (nl, SC_CONV, SC_WIDTH), SC_CONV ** -0.5),
        'cmp_k_pos': nrm(ks[10], (nl, CMP_BLOCK, NSA_HEAD_DIM), 0.02),
        'cmp_k_w1': nrm(ks[11], (nl, cmp_in, CMP_HIDDEN), cmp_in ** -0.5),
        'cmp_k_w2': nrm(ks[12], (nl, CMP_HIDDEN, NSA_HEAD_DIM), CMP_HIDDEN ** -0.5),
        'cmp_v_pos': nrm(ks[13], (nl, CMP_BLOCK, NSA_HEAD_DIM), 0.02),
        'cmp_v_w1': nrm(ks[14], (nl, cmp_in, CMP_HIDDEN), cmp_in ** -0.5),
        'cmp_v_w2': nrm(ks[15], (nl, CMP_HIDDEN, NSA_HEAD_DIM), CMP_HIDDEN ** -0.5),
        'w_out': nrm(ks[16], (nl, MIX_WIDTH, D_MODEL), MIX_WIDTH ** -0.5),
        'ffn_norm_w': 1.0 + nrm(ks[17], (nl, D_MODEL), 0.02),
        'ffn_w_up': nrm(ks[18], (nl, D_MODEL, 2 * D_FF), D_MODEL ** -0.5),
        'ffn_conv_w': nrm(ks[19], (nl, FFN_CONV, 2 * D_FF), FFN_CONV ** -0.5),
        'ffn_conv_b': nrm(ks[20], (nl, 2 * D_FF), 0.02),
        'ffn_w_down': nrm(ks[21], (nl, D_FF, D_MODEL), D_FF ** -0.5),
        'final_norm_w': 1.0 + nrm(ks[22], (D_MODEL,), 0.02),
    }


def reference(x, attn_norm_w, w_in, ssd_conv_w, ssd_conv_b, ssd_dt_bias, ssd_a_log, ssd_d,
              ssd_norm_w, sc_conv_w, cmp_k_pos, cmp_k_w1, cmp_k_w2, cmp_v_pos, cmp_v_w1, cmp_v_w2,
              w_out, ffn_norm_w, ffn_w_up, ffn_conv_w, ffn_conv_b, ffn_w_down, final_norm_w):
    s_len = x.shape[1]
    cos, sin = rope_tables(s_len)
    split_at = np.cumsum(np.array(IN_SIZES))[:-1].tolist()
    for l in range(DEPTH):
        h = rmsnorm(x, attn_norm_w[l])
        proj = h @ w_in[l]
        (z, xbc, dt_raw, sc_b, sc_c, sc_h, q, k_c, v_c, k_s, v_s, k_w, v_w,
         g_nsa) = jnp.split(proj, split_at, axis=-1)
        y_ssd = ssd_mixer(z, xbc, dt_raw, ssd_conv_w[l], ssd_conv_b[l], ssd_dt_bias[l],
                          ssd_a_log[l], ssd_d[l], ssd_norm_w[l])
        y_sc = sc_b * causal_dwconv(sc_c * sc_h, sc_conv_w[l])
        y_nsa = nsa_mixer(q, k_c, v_c, k_s, v_s, k_w, v_w, g_nsa, cos, sin,
                          cmp_k_pos[l], cmp_k_w1[l], cmp_k_w2[l],
                          cmp_v_pos[l], cmp_v_w1[l], cmp_v_w2[l])
        x = x + jnp.concatenate([y_ssd, y_sc, y_nsa], axis=-1) @ w_out[l]
        h = rmsnorm(x, ffn_norm_w[l])
        u = causal_dwconv(h @ ffn_w_up[l], ffn_conv_w[l], ffn_conv_b[l])
        gate, val = jnp.split(u, 2, axis=-1)
        x = x + (jax.nn.silu(gate) * val) @ ffn_w_down[l]
    return rmsnorm(x, final_norm_w)
```

```cpp
#include <hip/hip_runtime.h>
#include <hip/hip_cooperative_groups.h>
#include <cstdio>
namespace cg = cooperative_groups;

#ifndef REP_PH
#define REP_PH -1
#endif
#ifndef SINGLE_LAUNCH
#define SINGLE_LAUNCH 1
#endif

typedef unsigned short bf16_t;
typedef short bf16x8 __attribute__((ext_vector_type(8)));
typedef short s16x4 __attribute__((ext_vector_type(4)));
typedef short v4i16_t __attribute__((ext_vector_type(4)));
typedef float f32x4 __attribute__((ext_vector_type(4)));
typedef unsigned u32x4 __attribute__((ext_vector_type(4)));
typedef unsigned u32x2 __attribute__((ext_vector_type(2)));
#define LAS __attribute__((address_space(3)))
typedef LAS unsigned char* ldsp;

constexpr int NTOK = 32768, SEQ = 8192, DM = 1024, NP = 3072, DFF = 2752, NLAYER = 4;
constexpr int LDS_MAIN = 73728;
constexpr int LDS_BYTES = LDS_MAIN + 16;
constexpr int C_Z = 0, C_XBC = 512, C_SCB = 1536, C_SCC = 1792, C_SCH = 2048, C_Q = 2304, C_KC = 2560, C_VC = 2624,
              C_KS = 2688, C_VS = 2752, C_KW = 2816, C_VW = 2880, C_DT = 2944, C_G = 2952;

struct P {
  const float *x, *attn_norm_w, *w_in, *ssd_conv_w, *ssd_conv_b, *ssd_dt_bias, *ssd_a_log, *ssd_d, *ssd_norm_w, *sc_conv_w,
      *cmp_k_pos, *cmp_k_w1, *cmp_k_w2, *cmp_v_pos, *cmp_v_w1, *cmp_v_w2, *w_out, *ffn_norm_w, *ffn_w_up, *ffn_conv_w,
      *ffn_conv_b, *ffn_w_down, *final_norm_w;
  float* out;
  bf16_t *WinT, *WoutT, *WupT, *WdownT, *W1T, *zeros, *h, *proj, *ymix, *act, *states, *hid, *kcvc;
  float *c1, *rope, *cdec, *ssqp;
  unsigned* bar;
  bf16_t* cwh;
};

__device__ __forceinline__ int tidx() { int t = threadIdx.x; asm volatile("" : "+v"(t)); return t; }
typedef _Float16 h16x8 __attribute__((ext_vector_type(8)));
typedef _Float16 h16x2 __attribute__((ext_vector_type(2)));
__device__ __forceinline__ bf16_t f2bf(float f) { _Float16 h = (_Float16)f; return __builtin_bit_cast(unsigned short, h); }
__device__ __forceinline__ float bf2f(bf16_t b) { return (float)__builtin_bit_cast(_Float16, b); }
__device__ __forceinline__ unsigned pk2(float a, float b) { return __builtin_bit_cast(unsigned, __builtin_amdgcn_cvt_pkrtz(a, b)); }
__device__ __forceinline__ h16x2 as_h2(unsigned u) { return __builtin_bit_cast(h16x2, u); }
__device__ __forceinline__ float bflo(unsigned u) { return (float)__builtin_bit_cast(h16x2, u).x; }
__device__ __forceinline__ float bfhi(unsigned u) { return (float)__builtin_bit_cast(h16x2, u).y; }
__device__ __forceinline__ bf16x8 pack8(const float* v) {
  u32x4 u;
  u.x = pk2(v[0], v[1]); u.y = pk2(v[2], v[3]); u.z = pk2(v[4], v[5]); u.w = pk2(v[6], v[7]);
  return __builtin_bit_cast(bf16x8, u);
}
__device__ __forceinline__ bf16x8 pack44(f32x4 a, f32x4 b) {
  u32x4 u;
  u.x = pk2(a[0], a[1]); u.y = pk2(a[2], a[3]); u.z = pk2(b[0], b[1]); u.w = pk2(b[2], b[3]);
  return __builtin_bit_cast(bf16x8, u);
}
__device__ __forceinline__ bf16x8 pack44_rtz(f32x4 a, f32x4 b) {
  u32x4 u;
  u.x = __builtin_bit_cast(unsigned, __builtin_amdgcn_cvt_pkrtz(a[0], a[1])); u.y = __builtin_bit_cast(unsigned, __builtin_amdgcn_cvt_pkrtz(a[2], a[3]));
  u.z = __builtin_bit_cast(unsigned, __builtin_amdgcn_cvt_pkrtz(b[0], b[1])); u.w = __builtin_bit_cast(unsigned, __builtin_amdgcn_cvt_pkrtz(b[2], b[3]));
  return __builtin_bit_cast(bf16x8, u);
}
__device__ __forceinline__ void unpack8(u32x4 u, float* v) {
  v[0] = bflo(u.x); v[1] = bfhi(u.x); v[2] = bflo(u.y); v[3] = bfhi(u.y);
  v[4] = bflo(u.z); v[5] = bfhi(u.z); v[6] = bflo(u.w); v[7] = bfhi(u.w);
}
__device__ __forceinline__ bf16x8 ld128(ldsp p) { return *(LAS const bf16x8*)p; }
__device__ __forceinline__ void st128(ldsp p, u32x4 v) { *(LAS u32x4*)p = v; }
__device__ __forceinline__ s16x4 ldtr(ldsp p) {
  return __builtin_bit_cast(s16x4, __builtin_amdgcn_ds_read_tr16_b64_v4i16((LAS v4i16_t*)p));
}
__device__ __forceinline__ bf16x8 cat4(s16x4 a, s16x4 b) {
  bf16x8 r;
  r[0] = a[0]; r[1] = a[1]; r[2] = a[2]; r[3] = a[3]; r[4] = b[0]; r[5] = b[1]; r[6] = b[2]; r[7] = b[3];
  return r;
}
__device__ __forceinline__ float ldsf(ldsp p) { return *(LAS const float*)p; }
__device__ __forceinline__ unsigned ldsu(ldsp p) { return *(LAS const unsigned*)p; }
__device__ __forceinline__ void stsf(ldsp p, float v) { *(LAS float*)p = v; }
__device__ __forceinline__ void stsu(ldsp p, unsigned v) { *(LAS unsigned*)p = v; }
__device__ __forceinline__ f32x4 mfma16(bf16x8 a, bf16x8 b, f32x4 c) {
  return __builtin_amdgcn_mfma_f32_16x16x32_f16(__builtin_bit_cast(h16x8, a), __builtin_bit_cast(h16x8, b), c, 0, 0, 0);
}
__device__ __forceinline__ float ex2(float x) { return __builtin_amdgcn_exp2f(x); }
__device__ __forceinline__ float siluf(float x) { return x * __builtin_amdgcn_rcpf(1.f + __expf(-x)); }
__device__ __forceinline__ float sigmf(float x) { return __builtin_amdgcn_rcpf(1.f + __expf(-x)); }
__device__ __forceinline__ float softplusf(float x) { return x > 20.f ? x : log1pf(expf(x)); }
__device__ __forceinline__ float geluf(float x) {
  float u = 0.7978845608028654f * (x + 0.044715f * x * x * x);
  return 0.5f * x * (1.f + tanhf(u));
}
__device__ __forceinline__ u32x4 gld128(const bf16_t* p) { return *(const u32x4*)p; }
__device__ __forceinline__ long slab_idx(long row, int col, long nrows) { return ((long)(col >> 5) * nrows + row) * 32 + (col & 31); }

__device__ __forceinline__ int map_win(int n) {
  if (n < 1536) return n;
  if (n < 2944) return n + 8;
  if (n < 2952) return n - 2944 + 1536;
  if (n < 2964) return n;
  return -1;
}
__device__ __forceinline__ int map_wup(int n) {
  int j = n >> 7, r = n & 127;
  if (j >= 43) return -1;
  return r < 64 ? 64 * j + r : DFF + 64 * j + (r - 64);
}
__device__ __forceinline__ void transpose_tile(const float* src, int Nsrc, bf16_t* dst, int Ndst, int n0, int k0, int kind, ldsp smem,
                                               const float* kscale = nullptr) {
  const int tid = tidx();
  __syncthreads();
  {
    int nn = tid & 63;
    int n = n0 + nn;
    int sc = kind == 0 ? n : (kind == 1 ? map_win(n) : map_wup(n));
    for (int it = 0; it < 16; ++it) {
      int k = it * 4 + (tid >> 6);
      float v = sc >= 0 ? src[(long)(k0 + k) * Nsrc + sc] : 0.f;
      if (kscale) v *= kscale[k0 + k];
      stsf(smem + (k * 65 + nn) * 4, v);
    }
  }
  __syncthreads();
  {
    int nn = tid >> 2, kc = (tid & 3) * 16;
    float v[16];
    for (int e = 0; e < 16; ++e) v[e] = ldsf(smem + ((kc + e) * 65 + nn) * 4);
    u32x4 a, b;
    a.x = pk2(v[0], v[1]); a.y = pk2(v[2], v[3]); a.z = pk2(v[4], v[5]); a.w = pk2(v[6], v[7]);
    b.x = pk2(v[8], v[9]); b.y = pk2(v[10], v[11]); b.z = pk2(v[12], v[13]); b.w = pk2(v[14], v[15]);
    bf16_t* d = dst + slab_idx(n0 + nn, k0 + kc, Ndst);
    *(u32x4*)d = a;
    *(u32x4*)(d + 8) = b;
  }
}

constexpr int CV_WIN = 48 * 16, CV_WOUT = 16 * 16, CV_WUP = 88 * 16, CV_WDN = 16 * 43, CV_W1 = 2 * 32;
constexpr int CV_LAYER = CV_WIN + CV_WOUT + CV_WUP + CV_WDN + 2 * CV_W1;
constexpr int CV_ROPE = 1024, CV_C1 = 8, CV_TOTAL = NLAYER * CV_LAYER + CV_ROPE + CV_C1 + 1;

struct TDesc { const float* src; const float* kscale; bf16_t* dst; int Nsrc, Ndst, n0, k0, kind; };
__device__ __forceinline__ TDesc conv_desc(const P& p, int it) {
  TDesc d; d.kscale = nullptr; d.kind = 0;
  int l = it / CV_LAYER, r = it % CV_LAYER;
  if (r < CV_WIN) {
    d.src = p.w_in + (long)l * DM * 2964; d.Nsrc = 2964; d.dst = p.WinT + (long)l * NP * DM; d.Ndst = NP; d.n0 = (r / 16) * 64; d.k0 = (r % 16) * 64; d.kind = 1; d.kscale = p.attn_norm_w + l * DM;
  } else if ((r -= CV_WIN) < CV_WOUT) {
    d.src = p.w_out + (long)l * DM * DM; d.Nsrc = DM; d.dst = p.WoutT + (long)l * DM * DM; d.Ndst = DM; d.n0 = (r / 16) * 64; d.k0 = (r % 16) * 64;
  } else if ((r -= CV_WOUT) < CV_WUP) {
    d.src = p.ffn_w_up + (long)l * DM * 2 * DFF; d.Nsrc = 2 * DFF; d.dst = p.WupT + (long)l * 5632 * DM; d.Ndst = 5632; d.n0 = (r / 16) * 64; d.k0 = (r % 16) * 64; d.kind = 2; d.kscale = p.ffn_norm_w + l * DM;
  } else if ((r -= CV_WUP) < CV_WDN) {
    d.src = p.ffn_w_down + (long)l * DFF * DM; d.Nsrc = DM; d.dst = p.WdownT + (long)l * DM * DFF; d.Ndst = DM; d.n0 = (r / 43) * 64; d.k0 = (r % 43) * 64;
  } else if ((r -= CV_WDN) < CV_W1) {
    d.src = p.cmp_k_w1 + (long)l * 2048 * 128; d.Nsrc = 128; d.dst = p.W1T + (long)(l * 2 + 0) * 128 * 2048; d.Ndst = 128; d.n0 = (r / 32) * 64; d.k0 = (r % 32) * 64;
  } else {
    r -= CV_W1;
    d.src = p.cmp_v_w1 + (long)l * 2048 * 128; d.Nsrc = 128; d.dst = p.W1T + (long)(l * 2 + 1) * 128 * 2048; d.Ndst = 128; d.n0 = (r / 32) * 64; d.k0 = (r % 32) * 64;
  }
  return d;
}
__device__ __forceinline__ void transpose_group4(const P& p, int it0, ldsp smem) {
  const int tid = tidx();
  const int n4 = (tid & 15) * 4, kr = tid >> 4;
  float4 v[4][4];
  TDesc d[4];
#pragma unroll
  for (int t = 0; t < 4; ++t) {
    d[t] = conv_desc(p, it0 + t);
    const int n = d[t].n0 + n4;
    const int sc = d[t].kind == 0 ? n : (d[t].kind == 1 ? map_win(n) : map_wup(n));
#pragma unroll
    for (int q = 0; q < 4; ++q) {
      const int k = d[t].k0 + kr + 16 * q;
      v[t][q] = sc >= 0 ? *(const float4*)(d[t].src + (long)k * d[t].Nsrc + sc) : make_float4(0.f, 0.f, 0.f, 0.f);
      if (d[t].kscale) { const float ks = d[t].kscale[k]; v[t][q].x *= ks; v[t][q].y *= ks; v[t][q].z *= ks; v[t][q].w *= ks; }
    }
  }
  __syncthreads();
#pragma unroll
  for (int t = 0; t < 4; ++t)
#pragma unroll
    for (int q = 0; q < 4; ++q) {
      const ldsp b = smem + t * 16640 + ((kr + 16 * q) * 65 + n4) * 4;
      stsf(b, v[t][q].x); stsf(b + 4, v[t][q].y); stsf(b + 8, v[t][q].z); stsf(b + 12, v[t][q].w);
    }
  __syncthreads();
#pragma unroll
  for (int t = 0; t < 4; ++t) {
    const int nn = tid >> 2, kc = (tid & 3) * 16;
    float w[16];
#pragma unroll
    for (int e = 0; e < 16; ++e) w[e] = ldsf(smem + t * 16640 + ((kc + e) * 65 + nn) * 4);
    u32x4 a, b;
    a.x = pk2(w[0], w[1]); a.y = pk2(w[2], w[3]); a.z = pk2(w[4], w[5]); a.w = pk2(w[6], w[7]);
    b.x = pk2(w[8], w[9]); b.y = pk2(w[10], w[11]); b.z = pk2(w[12], w[13]); b.w = pk2(w[14], w[15]);
    bf16_t* dp = d[t].dst + slab_idx(d[t].n0 + nn, d[t].k0 + kc, d[t].Ndst);
    *(u32x4*)dp = a;
    *(u32x4*)(dp + 8) = b;
  }
}
__device__ __forceinline__ void ph_convert(const P& p, ldsp smem) {
  const int tid = tidx();
  for (int gi = blockIdx.x; gi < NLAYER * CV_LAYER / 4; gi += gridDim.x) transpose_group4(p, gi * 4, smem);
  for (int it = NLAYER * CV_LAYER + blockIdx.x; it < CV_TOTAL; it += gridDim.x) {
    if (it < NLAYER * CV_LAYER) {
      int l = it / CV_LAYER, r = it % CV_LAYER;
      if (r < CV_WIN) {
        transpose_tile(p.w_in + (long)l * DM * 2964, 2964, p.WinT + (long)l * NP * DM, NP, (r / 16) * 64, (r % 16) * 64, 1, smem, p.attn_norm_w + l * DM);
      } else if ((r -= CV_WIN) < CV_WOUT) {
        transpose_tile(p.w_out + (long)l * DM * DM, DM, p.WoutT + (long)l * DM * DM, DM, (r / 16) * 64, (r % 16) * 64, 0, smem);
      } else if ((r -= CV_WOUT) < CV_WUP) {
        transpose_tile(p.ffn_w_up + (long)l * DM * 2 * DFF, 2 * DFF, p.WupT + (long)l * 5632 * DM, 5632, (r / 16) * 64, (r % 16) * 64, 2, smem, p.ffn_norm_w + l * DM);
      } else if ((r -= CV_WUP) < CV_WDN) {
        transpose_tile(p.ffn_w_down + (long)l * DFF * DM, DM, p.WdownT + (long)l * DM * DFF, DM, (r / 43) * 64, (r % 43) * 64, 0, smem);
      } else if ((r -= CV_WDN) < CV_W1) {
        transpose_tile(p.cmp_k_w1 + (long)l * 2048 * 128, 128, p.W1T + (long)(l * 2 + 0) * 128 * 2048, 128, (r / 32) * 64, (r % 32) * 64, 0, smem);
      } else {
        r -= CV_W1;
        transpose_tile(p.cmp_v_w1 + (long)l * 2048 * 128, 128, p.W1T + (long)(l * 2 + 1) * 128 * 2048, 128, (r / 32) * 64, (r % 32) * 64, 0, smem);
      }
    } else {
      int r = it - NLAYER * CV_LAYER;
      if (r < CV_ROPE) {
        int idx = r * 256 + tid;
        int t = idx >> 5, d = idx & 31;
        float inv = 1.0f / powf(10000.0f, (float)d / 32.0f);
        float ang = (float)t * inv;
        p.rope[t * 64 + d] = cosf(ang);
        p.rope[t * 64 + 32 + d] = sinf(ang);
      } else if ((r -= CV_ROPE) < CV_C1) {
        int l = r >> 1, kv = r & 1;
        const float* pos = (kv ? p.cmp_v_pos : p.cmp_k_pos) + (long)l * 2048;
        const float* w1 = (kv ? p.cmp_v_w1 : p.cmp_k_w1) + (long)l * 2048 * 128;
        const int n4 = (tid & 31) * 4, kg = tid >> 5;
        float4 ac = make_float4(0.f, 0.f, 0.f, 0.f);
#pragma unroll 8
        for (int k = kg * 256; k < kg * 256 + 256; ++k) {
          const float pk = pos[k];
          const float4 wv4 = *(const float4*)(w1 + (long)k * 128 + n4);
          ac.x += pk * wv4.x; ac.y += pk * wv4.y; ac.z += pk * wv4.z; ac.w += pk * wv4.w;
        }
        __syncthreads();
        stsf(smem + (kg * 128 + n4) * 4, ac.x); stsf(smem + (kg * 128 + n4 + 1) * 4, ac.y);
        stsf(smem + (kg * 128 + n4 + 2) * 4, ac.z); stsf(smem + (kg * 128 + n4 + 3) * 4, ac.w);
        __syncthreads();
        if (tid < 128) {
          float sacc = 0.f;
#pragma unroll
          for (int gq = 0; gq < 8; ++gq) sacc += ldsf(smem + (gq * 128 + tid) * 4);
          p.c1[(l * 2 + kv) * 128 + tid] = sacc;
        }
      } else {
        for (int e = tid; e < 2048; e += 256) p.zeros[e] = 0;
        for (int e2 = tid; e2 < NLAYER * 5 * 512; e2 += 256) {
          const int e = 2 * e2, l2 = e / 5120, r2 = (e % 5120) >> 10, c2 = e & 1023;
          const float* src = r2 < 4 ? p.ssd_conv_w + (long)l2 * 4096 + r2 * 1024 + c2 : p.ssd_conv_b + l2 * 1024 + c2;
          ((unsigned*)p.cwh)[e2] = pk2(src[0], src[1]);
        }
      }
    }
  }
}

__device__ __forceinline__ void ph_prepass(const P& p) {
  const int wave = tidx() >> 6, lane = tidx() & 63;
  for (int row = blockIdx.x * 4 + wave; row < NTOK; row += gridDim.x * 4) {
    const float4* xr = (const float4*)(p.x + (long)row * DM);
    float ss = 0.f;
#pragma unroll
    for (int k = 0; k < 4; ++k) {
      float4 v = xr[lane + 64 * k];
      ss += v.x * v.x + v.y * v.y + v.z * v.z + v.w * v.w;
      u32x2 o; o.x = pk2(v.x, v.y); o.y = pk2(v.z, v.w);
      *(u32x2*)(p.h + slab_idx(row, (lane + 64 * k) * 4, NTOK)) = o;
    }
#pragma unroll
    for (int o = 32; o >= 1; o >>= 1) ss += __shfl_xor(ss, o);
    if (lane < 8) p.ssqp[(long)row * 8 + lane] = lane == 0 ? ss : 0.f;
  }
}
__device__ __forceinline__ float row_rstd(const float* ssqp, long row) {
  float4 a = *(const float4*)(ssqp + row * 8), b = *(const float4*)(ssqp + row * 8 + 4);
  float ss = ((a.x + a.y) + (a.z + a.w)) + ((b.x + b.y) + (b.z + b.w));
  return rsqrtf(ss * (1.f / 1024.f) + 1e-6f);
}
__device__ __forceinline__ void ph_final(const P& p) {
  const int wave = tidx() >> 6, lane = tidx() & 63;
  for (int row = blockIdx.x * 4 + wave; row < NTOK; row += gridDim.x * 4) {
    float4 v[4];
    float ss = 0.f;
#pragma unroll
    for (int k = 0; k < 4; ++k) {
      u32x2 hv = *(const u32x2*)(p.h + slab_idx(row, (lane + 64 * k) * 4, NTOK));
      v[k].x = bflo(hv.x); v[k].y = bfhi(hv.x); v[k].z = bflo(hv.y); v[k].w = bfhi(hv.y);
      ss += v[k].x * v[k].x + v[k].y * v[k].y + v[k].z * v[k].z + v[k].w * v[k].w;
    }
#pragma unroll
    for (int o = 32; o >= 1; o >>= 1) ss += __shfl_xor(ss, o);
    const float rstd = rsqrtf(ss * (1.f / 1024.f) + 1e-6f);
#pragma unroll
    for (int k = 0; k < 4; ++k) {
      float4 w4 = ((const float4*)p.final_norm_w)[lane + 64 * k];
      float4 o; o.x = v[k].x * rstd * w4.x; o.y = v[k].y * rstd * w4.y; o.z = v[k].z * rstd * w4.z; o.w = v[k].w * rstd * w4.w;
      ((float4*)(p.out + (long)row * DM))[lane + 64 * k] = o;
    }
  }
}
__device__ __forceinline__ void ph_rmsnorm(const float* x, const float* w, bf16_t* h, float* outf) {
  const int wave = tidx() >> 6, lane = tidx() & 63;
  for (int row = blockIdx.x * 4 + wave; row < NTOK; row += gridDim.x * 4) {
    const float4* xr = (const float4*)(x + (long)row * DM);
    float4 v[4];
    float ss = 0.f;
#pragma unroll
    for (int k = 0; k < 4; ++k) {
      v[k] = xr[lane + 64 * k];
      ss += v[k].x * v[k].x + v[k].y * v[k].y + v[k].z * v[k].z + v[k].w * v[k].w;
    }
#pragma unroll
    for (int o = 32; o >= 1; o >>= 1) ss += __shfl_xor(ss, o);
    float rstd = rsqrtf(ss * (1.f / 1024.f) + 1e-6f);
#pragma unroll
    for (int k = 0; k < 4; ++k) {
      float4 w4 = ((const float4*)w)[lane + 64 * k];
      float a = v[k].x * rstd * w4.x, b = v[k].y * rstd * w4.y, c = v[k].z * rstd * w4.z, d = v[k].w * rstd * w4.w;
      if (h) {
        u32x2 o; o.x = pk2(a, b); o.y = pk2(c, d);
        *(u32x2*)(h + slab_idx(row, (lane + 64 * k) * 4, NTOK)) = o;
      } else {
        float4 o; o.x = a; o.y = b; o.z = c; o.w = d;
        ((float4*)(outf + (long)row * DM))[lane + 64 * k] = o;
      }
    }
  }
}

constexpr int GSTAGE = 24576;
__device__ __forceinline__ int gemm_chunk_off() {
  const int t = tidx();
  const int sq = (t >> 4) & 3;
  const int sv = (0x78 >> (2 * sq)) & 3;
  return ((t & 3) ^ sv) * 8;
}
__device__ __forceinline__ const char* uniform_ptr(const char* p) {
  unsigned long long v = (unsigned long long)p;
  unsigned lo = __builtin_amdgcn_readfirstlane((unsigned)v), hi = __builtin_amdgcn_readfirstlane((unsigned)(v >> 32));
  asm volatile("" : "+s"(lo), "+s"(hi));
  return (const char*)(((unsigned long long)hi << 32) | lo);
}
template <bool CMPA>
__device__ __forceinline__ void gemm_core(f32x4 (&acc)[8][4], const char* abase, const unsigned (&voffA)[2], size_t astep, const char* bbase,
                                          const unsigned (&voffB)[4], size_t bstep, int nk, ldsp smem) {
  const int tid = tidx(), lane = tid & 63, wid = tid >> 6, wr = wid >> 1, wc = wid & 1, i = lane & 15, g = lane >> 4;
#pragma unroll
  for (int nf = 0; nf < 8; ++nf)
#pragma unroll
    for (int mf = 0; mf < 4; ++mf) acc[nf][mf] = (f32x4){0.f, 0.f, 0.f, 0.f};
  asm volatile("s_waitcnt vmcnt(0)" ::: "memory");
  __syncthreads();
  const int wbase = __builtin_amdgcn_readfirstlane(tid >> 6) * 1024;
  auto stage = [&](int kt, int buf) {
    const char* ak = uniform_ptr(abase + (CMPA ? ((size_t)(kt >> 1) * NP + (kt & 1) * 32) * 2 : (size_t)kt * astep));
    const char* bk = uniform_ptr(bbase + (size_t)kt * bstep);
#pragma unroll
    for (int q = 0; q < 2; ++q)
      __builtin_amdgcn_global_load_lds((const unsigned*)(ak + voffA[q]), (LAS unsigned*)(smem + buf * GSTAGE + wbase + q * 4096), 16, 0, 0);
#pragma unroll
    for (int q = 0; q < 4; ++q)
      __builtin_amdgcn_global_load_lds((const unsigned*)(bk + voffB[q]), (LAS unsigned*)(smem + buf * GSTAGE + 8192 + wbase + q * 4096), 16, 0, 0);
  };
  stage(0, 0);
  if (nk > 1) stage(1, 1);
  const int sq = (i >> 2) & 3;
  const int sw = (g ^ ((0x78 >> (2 * sq)) & 3)) * 16;
  int buf = 0, nbuf = 2;
  for (int kt = 0; kt < nk; ++kt) {
    if (kt + 1 < nk) asm volatile("s_waitcnt vmcnt(6)" ::: "memory");
    else asm volatile("s_waitcnt vmcnt(0)" ::: "memory");
    __builtin_amdgcn_s_barrier();
    asm volatile("" ::: "memory");
    ldsp sa = smem + buf * GSTAGE, sb = sa + 8192;
    bf16x8 a[4], b0[4];
#pragma unroll
    for (int mf = 0; mf < 4; ++mf) a[mf] = ld128(sa + (wr * 64 + mf * 16 + i) * 64 + sw);
#pragma unroll
    for (int nf = 0; nf < 4; ++nf) b0[nf] = ld128(sb + (wc * 128 + nf * 16 + i) * 64 + sw);
    if (kt + 2 < nk) stage(kt + 2, nbuf);
    __builtin_amdgcn_s_setprio(1);
#pragma unroll
    for (int nf = 0; nf < 4; ++nf)
#pragma unroll
      for (int mf = 0; mf < 4; ++mf) acc[nf][mf] = mfma16(b0[nf], a[mf], acc[nf][mf]);
    __builtin_amdgcn_s_setprio(0);
    {
      bf16x8 b[4];
#pragma unroll
      for (int nf = 0; nf < 4; ++nf) b[nf] = ld128(sb + (wc * 128 + (4 + nf) * 16 + i) * 64 + sw);
      __builtin_amdgcn_s_setprio(1);
#pragma unroll
      for (int nf = 0; nf < 4; ++nf)
#pragma unroll
        for (int mf = 0; mf < 4; ++mf) acc[4 + nf][mf] = mfma16(b[nf], a[mf], acc[4 + nf][mf]);
      __builtin_amdgcn_s_setprio(0);
    }
    buf = buf == 2 ? 0 : buf + 1;
    nbuf = nbuf == 2 ? 0 : nbuf + 1;
  }
  __syncthreads();
}
__device__ __forceinline__ void tile_map(int t, int NT, int& mt, int& nt) {
  int xcd = t & 7, local = t >> 3;
  nt = local % NT;
  mt = (local / NT) * 8 + xcd;
}

__device__ __forceinline__ void ph_inproj(const P& p, int layer, ldsp smem) {
  const int tid = tidx(), lane = tid & 63, wid = tid >> 6, wr = wid >> 1, wc = wid & 1, i = lane & 15, g = lane >> 4;
  const bf16_t* Bt = p.WinT + (long)layer * NP * DM;
  const int co = gemm_chunk_off();
  for (int tile = blockIdx.x; tile < 256 * 12; tile += gridDim.x) {
    int mt, nt;
    tile_map(tile, 12, mt, nt);
    int m0 = mt * 128, n0 = nt * 256;
    unsigned voffA[2], voffB[4];
#pragma unroll
    for (int q = 0; q < 2; ++q) voffA[q] = (unsigned)(((tid >> 2) + 64 * q) * 32 + co) * 2u;
#pragma unroll
    for (int q = 0; q < 4; ++q) voffB[q] = (unsigned)(((tid >> 2) + 64 * q) * 32 + co) * 2u;
    f32x4 acc[8][4];
    gemm_core<false>(acc, (const char*)(p.h + (long)m0 * 32), voffA, (size_t)NTOK * 64, (const char*)(Bt + (long)n0 * 32), voffB, (size_t)NP * 64, DM / 32, smem);
#pragma unroll
    for (int mf = 0; mf < 4; ++mf) {
      const float rs = row_rstd(p.ssqp, m0 + wr * 64 + mf * 16 + i);
#pragma unroll
      for (int nf = 0; nf < 8; ++nf) acc[nf][mf] *= rs;
    }
#pragma unroll
    for (int hh = 0; hh < 2; ++hh) {
      int unit = (n0 + wc * 128 + hh * 64) >> 6;
      bool dorope = (unit >= 36 && unit <= 40) || unit == 42 || unit == 44;
      float qs = (unit >= 36 && unit <= 39) ? 0.125f * 1.4426950408889634f : 1.0f;
#pragma unroll
      for (int mf = 0; mf < 4; ++mf) {
        int row = m0 + wr * 64 + mf * 16 + i;
        if (dorope) {
          int t = row & (SEQ - 1);
#pragma unroll
          for (int n = 0; n < 2; ++n) {
            float4 c4 = *(const float4*)(p.rope + t * 64 + n * 16 + 4 * g);
            float4 s4 = *(const float4*)(p.rope + t * 64 + 32 + n * 16 + 4 * g);
            const float cc[4] = {c4.x, c4.y, c4.z, c4.w}, ss[4] = {s4.x, s4.y, s4.z, s4.w};
#pragma unroll
            for (int r = 0; r < 4; ++r) {
              float x1 = acc[hh * 4 + n][mf][r], x2 = acc[hh * 4 + n + 2][mf][r];
              acc[hh * 4 + n][mf][r] = (x1 * cc[r] - x2 * ss[r]) * qs;
              acc[hh * 4 + n + 2][mf][r] = (x2 * cc[r] + x1 * ss[r]) * qs;
            }
          }
        }
#pragma unroll
        for (int n = 0; n < 4; ++n) {
          f32x4 v = acc[hh * 4 + n][mf];
          u32x2 o; o.x = pk2(v[0], v[1]); o.y = pk2(v[2], v[3]);
          *(u32x2*)(p.proj + (long)row * NP + n0 + wc * 128 + (hh * 4 + n) * 16 + 4 * g) = o;
        }
      }
    }
  }
}

__device__ __forceinline__ void ph_resgemm(const bf16_t* A, int K, const bf16_t* Bt, bf16_t* hout, float* ssqp, ldsp smem) {
  const int tid = tidx(), lane = tid & 63, wid = tid >> 6, wr = wid >> 1, wc = wid & 1, i = lane & 15, g = lane >> 4;
  const int co = gemm_chunk_off();
  for (int tile = blockIdx.x; tile < 256 * 4; tile += gridDim.x) {
    int mt, nt;
    tile_map(tile, 4, mt, nt);
    int m0 = mt * 128, n0 = nt * 256;
    unsigned voffA[2], voffB[4];
#pragma unroll
    for (int q = 0; q < 2; ++q) voffA[q] = (unsigned)(((tid >> 2) + 64 * q) * 32 + co) * 2u;
#pragma unroll
    for (int q = 0; q < 4; ++q) voffB[q] = (unsigned)(((tid >> 2) + 64 * q) * 32 + co) * 2u;
    f32x4 acc[8][4];
    gemm_core<false>(acc, (const char*)(A + (long)m0 * 32), voffA, (size_t)NTOK * 64, (const char*)(Bt + (long)n0 * 32), voffB, (size_t)DM * 64, K / 32, smem);
#pragma unroll
    for (int mf = 0; mf < 4; ++mf) {
      long row = m0 + wr * 64 + mf * 16 + i;
      u32x2 xi[8];
#pragma unroll
      for (int nf = 0; nf < 8; ++nf) xi[nf] = *(const u32x2*)(hout + slab_idx(row, n0 + wc * 128 + nf * 16 + 4 * g, NTOK));
      float ss = 0.f;
#pragma unroll
      for (int nf = 0; nf < 8; ++nf) {
        f32x4 v = acc[nf][mf];
        float4 o; o.x = bflo(xi[nf].x) + v[0]; o.y = bfhi(xi[nf].x) + v[1]; o.z = bflo(xi[nf].y) + v[2]; o.w = bfhi(xi[nf].y) + v[3];
        ss += o.x * o.x + o.y * o.y + o.z * o.z + o.w * o.w;
        u32x2 hb; hb.x = pk2(o.x, o.y); hb.y = pk2(o.z, o.w);
        *(u32x2*)(hout + slab_idx(row, n0 + wc * 128 + nf * 16 + 4 * g, NTOK)) = hb;
      }
      ss += __shfl_xor(ss, 16);
      ss += __shfl_xor(ss, 32);
      if (g == 0) ssqp[row * 8 + nt * 2 + wc] = ss;
      asm volatile("" ::: "memory");
    }
  }
}

__device__ __forceinline__ void cmp_gemm1_tile(const P& p, int layer, int item, ldsp smem) {
  asm volatile("" : "+s"(layer));
  const int tid = tidx(), lane = tid & 63, wid = tid >> 6, wr = wid >> 1, wc = wid & 1, i = lane & 15, g = lane >> 4;
  const int co = gemm_chunk_off();
  int kv = item >> 4, mt = item & 15;
  int m0 = mt * 128;
  const bf16_t* A = p.proj + (kv ? C_VC : C_KC);
  const bf16_t* Bt = p.W1T + (long)(layer * 2 + kv) * 128 * 2048;
  unsigned voffA[2], voffB[4];
#pragma unroll
  for (int q = 0; q < 2; ++q) voffA[q] = (unsigned)(((tid >> 2) + 64 * q) * 16 * NP + co) * 2u;
#pragma unroll
  for (int q = 0; q < 4; ++q) voffB[q] = (unsigned)(((tid >> 2) + 64 * (q & 1)) * 32 + co) * 2u;
  f32x4 acc[8][4];
  gemm_core<true>(acc, (const char*)(A + (long)m0 * 16 * NP), voffA, 0, (const char*)Bt, voffB, (size_t)128 * 64, 64, smem);
  const float* c1 = p.c1 + (layer * 2 + kv) * 128;
  bf16_t* hid = p.hid + (long)kv * 2048 * 128;
  if (wc == 0) {
#pragma unroll
    for (int mf = 0; mf < 4; ++mf) {
      int row = m0 + wr * 64 + mf * 16 + i;
#pragma unroll
      for (int nf = 0; nf < 8; ++nf) {
        int col = nf * 16 + 4 * g;
        float4 cb = *(const float4*)(c1 + col);
        f32x4 v = acc[nf][mf];
        u32x2 o;
        o.x = pk2(geluf(v[0] + cb.x), geluf(v[1] + cb.y));
        o.y = pk2(geluf(v[2] + cb.z), geluf(v[3] + cb.w));
        *(u32x2*)(hid + (long)row * 128 + col) = o;
      }
    }
  }
}

__device__ __forceinline__ void ph_ffn_up(const P& p, int layer, ldsp smem) {
  const int tid = tidx(), lane = tid & 63, wid = tid >> 6, wr = wid >> 1, wc = wid & 1, i = lane & 15, g = lane >> 4;
  const int co = gemm_chunk_off();
  const bf16_t* Bt = p.WupT + (long)layer * 5632 * DM;
  const float* cw = p.ffn_conv_w + (long)layer * 3 * 2 * DFF;
  const float* cb = p.ffn_conv_b + (long)layer * 2 * DFF;
  constexpr int MT = 264, NT = 22;
  for (int tile = blockIdx.x; tile < MT * NT; tile += gridDim.x) {
    int mtb, nt;
    tile_map(tile, NT, mtb, nt);
    int b = mtb / 66, mj = mtb % 66;
    int tokbase = 126 * mj - 2;
    unsigned voffA[2], voffB[4];
#pragma unroll
    for (int q = 0; q < 2; ++q) {
      int tk = tokbase + (tid >> 2) + 64 * q;
      tk = tk < 0 ? 0 : (tk >= SEQ ? SEQ - 1 : tk);
      voffA[q] = (unsigned)(tk * 32 + co) * 2u;
    }
#pragma unroll
    for (int q = 0; q < 4; ++q) voffB[q] = (unsigned)(((tid >> 2) + 64 * q) * 32 + co) * 2u;
    f32x4 acc[8][4];
    gemm_core<false>(acc, (const char*)(p.h + (long)b * SEQ * 32), voffA, (size_t)NTOK * 64, (const char*)(Bt + (long)nt * 256 * 32), voffB, (size_t)5632 * 64, DM / 32, smem);
#pragma unroll
    for (int mf = 0; mf < 4; ++mf) {
      const int tkr = tokbase + wr * 64 + mf * 16 + i;
      const float rs = (tkr >= 0 && tkr < SEQ) ? row_rstd(p.ssqp, (long)b * SEQ + tkr) : 0.f;
#pragma unroll
      for (int nf = 0; nf < 8; ++nf) {
        int r = wr * 64 + mf * 16 + i, c = wc * 128 + nf * 16 + 4 * g;
        f32x4 v = acc[nf][mf] * rs;
        u32x2 o; o.x = pk2(v[0], v[1]); o.y = pk2(v[2], v[3]);
        *(LAS u32x2*)(smem + r * 528 + c * 2) = o;
      }
    }
    __syncthreads();
    {
      const int ac = (tid & 15) * 8;
      const int pi = ac >> 6, pc = ac & 63;
      const int pair = 2 * nt + pi;
      if (pair < 43) {
        const int gcol = pair * 64 + pc;
        const int lg = (pi * 128 + pc) * 2, lv = (pi * 128 + 64 + pc) * 2;
        h16x2 wg[3][4], wv[3][4], bg[4], bv[4];
#pragma unroll
        for (int q = 0; q < 4; ++q) {
#pragma unroll
          for (int j = 0; j < 3; ++j) {
            const float2 a2 = *(const float2*)(cw + j * 2 * DFF + gcol + 2 * q), b2 = *(const float2*)(cw + j * 2 * DFF + DFF + gcol + 2 * q);
            wg[j][q].x = (_Float16)a2.x; wg[j][q].y = (_Float16)a2.y;
            wv[j][q].x = (_Float16)b2.x; wv[j][q].y = (_Float16)b2.y;
          }
          const float2 c2 = *(const float2*)(cb + gcol + 2 * q), d2 = *(const float2*)(cb + DFF + gcol + 2 * q);
          bg[q].x = (_Float16)c2.x; bg[q].y = (_Float16)c2.y;
          bv[q].x = (_Float16)d2.x; bv[q].y = (_Float16)d2.y;
        }
#pragma unroll 2
        for (int it = 0; it < 8; ++it) {
          int r = 2 + (tid >> 4) + 16 * it;
          int tk = tokbase + r;
          if (r < 128 && tk < SEQ) {
            h16x2 ga[4], va[4];
#pragma unroll
            for (int q = 0; q < 4; ++q) { ga[q] = bg[q]; va[q] = bv[q]; }
#pragma unroll
            for (int j = 0; j < 3; ++j) {
              const u32x4 tg = *(LAS const u32x4*)(smem + (r - 2 + j) * 528 + lg);
              const u32x4 tv = *(LAS const u32x4*)(smem + (r - 2 + j) * 528 + lv);
              const unsigned tgs[4] = {tg.x, tg.y, tg.z, tg.w}, tvs[4] = {tv.x, tv.y, tv.z, tv.w};
#pragma unroll
              for (int q = 0; q < 4; ++q) {
                ga[q] = wg[j][q] * __builtin_bit_cast(h16x2, tgs[q]) + ga[q];
                va[q] = wv[j][q] * __builtin_bit_cast(h16x2, tvs[q]) + va[q];
              }
            }
            u32x4 ov;
            unsigned ow[4];
#pragma unroll
            for (int q = 0; q < 4; ++q) ow[q] = pk2(siluf((float)ga[q].x) * (float)va[q].x, siluf((float)ga[q].y) * (float)va[q].y);
            ov.x = ow[0]; ov.y = ow[1]; ov.z = ow[2]; ov.w = ow[3];
            *(u32x4*)(p.act + slab_idx((long)b * SEQ + tk, gcol, NTOK)) = ov;
          }
        }
      }
    }
  }
}

__device__ __forceinline__ void xbc_conv8(const P& p, int layer, long row, int tb, int ccol, float* o) {
  const bf16_t* wh = p.cwh + (long)layer * 5120 + ccol;
  const u32x4 bb = gld128(wh + 4096);
  h16x2 acc0 = as_h2(bb.x), acc1 = as_h2(bb.y), acc2 = as_h2(bb.z), acc3 = as_h2(bb.w);
#pragma unroll
  for (int j = 0; j < 4; ++j) {
    if (tb - 3 + j >= 0) {
      const u32x4 v = gld128(p.proj + (row - 3 + j) * NP + C_XBC + ccol);
      const u32x4 w = gld128(wh + j * 1024);
      acc0 = as_h2(w.x) * as_h2(v.x) + acc0;
      acc1 = as_h2(w.y) * as_h2(v.y) + acc1;
      acc2 = as_h2(w.z) * as_h2(v.z) + acc2;
      acc3 = as_h2(w.w) * as_h2(v.w) + acc3;
    }
  }
  o[0] = siluf((float)acc0.x); o[1] = siluf((float)acc0.y); o[2] = siluf((float)acc1.x); o[3] = siluf((float)acc1.y);
  o[4] = siluf((float)acc2.x); o[5] = siluf((float)acc2.y); o[6] = siluf((float)acc3.x); o[7] = siluf((float)acc3.y);
}

__device__ __forceinline__ void ssd_dt_scan(const P& p, int layer, long row0, int hd, int lane, ldsp dts, ldsp acs) {
  float dtr = bf2f(p.proj[(row0 + lane) * NP + C_DT + hd]) + p.ssd_dt_bias[layer * 8 + hd];
  float dt = softplusf(dtr);
  float a = -dt * expf(p.ssd_a_log[layer * 8 + hd]);
  float cs = a;
#pragma unroll
  for (int o = 1; o < 64; o <<= 1) {
    float t = __shfl_up(cs, o);
    if (lane >= o) cs += t;
  }
  stsf(dts + lane * 4, dt);
  stsf(acs + lane * 4, cs);
}

__device__ __forceinline__ void ssd1_item(const P& p, int layer, int item, ldsp smem) {
  asm volatile("" : "+s"(layer));
  const int tid = tidx(), lane = tid & 63, w = tid >> 6, i = lane & 15, g = lane >> 4;
  int b = item >> 8, c = (item >> 1) & 127, grp = item & 1;
  long row0 = (long)b * SEQ + c * 64;
  int tb0 = c * 64;
  ldsp Bs = smem, Xs = smem + 17408, dts = smem + 51200, acs = smem + 52224;
  __syncthreads();
  ssd_dt_scan(p, layer, row0, 4 * grp + w, lane, dts + w * 256, acs + w * 256);
  __syncthreads();
#pragma unroll 1
  for (int it = 0; it < 4; ++it) {
    int r = (tid >> 4) + 16 * it, ch = tid & 15;
    float o[8];
    xbc_conv8(p, layer, row0 + r, tb0 + r, 512 + 128 * grp + ch * 8, o);
    st128(Bs + r * 272 + ch * 16, __builtin_bit_cast(u32x4, pack8(o)));
  }
#pragma unroll 2
  for (int it = 0; it < 8; ++it) {
    int r = (tid >> 5) + 8 * it, ch = tid & 31;
    int hh = ch >> 3;
    float o[8];
    xbc_conv8(p, layer, row0 + r, tb0 + r, (4 * grp) * 64 + ch * 8, o);
    float sc = ldsf(dts + hh * 256 + r * 4) * __expf(ldsf(acs + hh * 256 + 63 * 4) - ldsf(acs + hh * 256 + r * 4));
#pragma unroll
    for (int e = 0; e < 8; ++e) o[e] *= sc;
    st128(Xs + r * 528 + ch * 16, __builtin_bit_cast(u32x4, pack8(o)));
  }
  __syncthreads();
  int hd = 4 * grp + w;
  bf16_t* st = p.states + (((long)b * 128 + c) * 8 + hd) * 8192;
#pragma unroll 1
  for (int nh = 0; nh < 2; ++nh) {
    f32x4 acc[4][4];
#pragma unroll
    for (int pf = 0; pf < 4; ++pf)
#pragma unroll
      for (int nf = 0; nf < 4; ++nf) acc[pf][nf] = (f32x4){0.f, 0.f, 0.f, 0.f};
#pragma unroll
    for (int ks = 0; ks < 2; ++ks) {
      bf16x8 af[4], bfr[4];
      int rr = 32 * ks + 8 * g + (i >> 2);
#pragma unroll
      for (int pf = 0; pf < 4; ++pf) {
        ldsp a = Xs + rr * 528 + (64 * w + 16 * pf + 4 * (i & 3)) * 2;
        af[pf] = cat4(ldtr(a), ldtr(a + 4 * 528));
      }
#pragma unroll
      for (int nf = 0; nf < 4; ++nf) {
        ldsp a = Bs + rr * 272 + (16 * (4 * nh + nf) + 4 * (i & 3)) * 2;
        bfr[nf] = cat4(ldtr(a), ldtr(a + 4 * 272));
      }
#pragma unroll
      for (int pf = 0; pf < 4; ++pf)
#pragma unroll
        for (int nf = 0; nf < 4; ++nf) acc[pf][nf] = mfma16(bfr[nf], af[pf], acc[pf][nf]);
    }
#pragma unroll
    for (int pf = 0; pf < 4; ++pf)
#pragma unroll
      for (int nf = 0; nf < 4; ++nf)
      {
        const f32x4 v = acc[pf][nf];
        u32x2 o; o.x = pk2(v[0], v[1]); o.y = pk2(v[2], v[3]);
        *(u32x2*)(st + (16 * pf + i) * 128 + 16 * (4 * nh + nf) + 4 * g) = o;
      }
  }
  if (lane == 0) p.cdec[((long)b * 128 + c) * 8 + hd] = __expf(ldsf(acs + w * 256 + 63 * 4));
}

__device__ __forceinline__ void ssd2_item(const P& p, int item) {
  asm volatile("" : "+s"(item));
  int idx = item * 256 + tidx();
  int bh = idx >> 12, e = idx & 4095;
  int b = bh >> 3, hd = bh & 7;
  unsigned* S = (unsigned*)p.states;
  float h0 = 0.f, h1 = 0.f;
  for (int c0 = 0; c0 < 128; c0 += 32) {
    unsigned v[32]; float dc[32];
#pragma unroll
    for (int u = 0; u < 32; ++u) {
      long cb = ((long)b * 128 + c0 + u) * 8 + hd;
      v[u] = S[cb * 4096 + e];
      dc[u] = p.cdec[cb];
    }
#pragma unroll
    for (int u = 0; u < 32; ++u) {
      long cb = ((long)b * 128 + c0 + u) * 8 + hd;
      S[cb * 4096 + e] = pk2(h0, h1);
      h0 = h0 * dc[u] + bflo(v[u]);
      h1 = h1 * dc[u] + bfhi(v[u]);
    }
  }
}

__device__ __forceinline__ void cmp_gemm2_item(const P& p, int layer, int item) {
  asm volatile("" : "+s"(layer));
  int idx = item * 256 + tidx();
  int kv = idx >> 17, m = (idx >> 6) & 2047, d = idx & 63;
  const float* w2 = (kv ? p.cmp_v_w2 : p.cmp_k_w2) + (long)layer * 128 * 64;
  const bf16_t* hr = p.hid + ((long)kv * 2048 + m) * 128;
  float s = 0.f;
  if ((m & 511) != 511) {
    for (int n8 = 0; n8 < 16; ++n8) {
      float v[8];
      unpack8(gld128(hr + n8 * 8), v);
#pragma unroll
      for (int e = 0; e < 8; ++e) s += v[e] * w2[(n8 * 8 + e) * 64 + d];
    }
  }
  p.kcvc[((long)kv * 2048 + m) * 64 + d] = f2bf(s);
}

__device__ __forceinline__ void shortconv_item(const P& p, int layer, int item) {
  asm volatile("" : "+s"(layer));
  const int tid = tidx();
  const float* cw = p.sc_conv_w + (long)layer * 3 * 256;
  for (int it = 0; it < 8; ++it) {
    int q = it * 256 + tid;
    int r = q >> 5, ch = q & 31;
    long row = (long)item * 64 + r;
    int tb = (int)(row & (SEQ - 1));
    float o[8];
#pragma unroll
    for (int e = 0; e < 8; ++e) o[e] = 0.f;
#pragma unroll
    for (int j = 0; j < 3; ++j) {
      if (tb - 2 + j >= 0) {
        float a[8], bb[8];
        unpack8(gld128(p.proj + (row - 2 + j) * NP + C_SCC + ch * 8), a);
        unpack8(gld128(p.proj + (row - 2 + j) * NP + C_SCH + ch * 8), bb);
#pragma unroll
        for (int e = 0; e < 8; ++e) o[e] += cw[j * 256 + ch * 8 + e] * (a[e] * bb[e]);
      }
    }
    float sb[8];
    unpack8(gld128(p.proj + row * NP + C_SCB + ch * 8), sb);
#pragma unroll
    for (int e = 0; e < 8; ++e) o[e] *= sb[e];
    *(u32x4*)(p.ymix + slab_idx(row, 512 + ch * 8, NTOK)) = __builtin_bit_cast(u32x4, pack8(o));
  }
}

__device__ __forceinline__ void ssd3_item(const P& p, int layer, int item, ldsp smem) {
  asm volatile("" : "+s"(layer));
  const int tid = tidx(), lane = tid & 63, w = tid >> 6, i = lane & 15, g = lane >> 4;
  int b = item >> 7, c = item & 127;
  long row0 = (long)b * SEQ + c * 64;
  int tb0 = c * 64;
  ldsp Cs = smem, Bs = smem + 17408, Xh = smem + 34816, dts = smem + 44032, acs = smem + 45056;
  float ssq = 0.f;
  const int lq = 16 * w + i;
#pragma unroll 1
  for (int grp = 0; grp < 2; ++grp) {
    __syncthreads();
    ssd_dt_scan(p, layer, row0, 4 * grp + w, lane, dts + w * 256, acs + w * 256);
    for (int it = 0; it < 4; ++it) {
      int r = (tid >> 4) + 16 * it, ch = tid & 15;
      float o[8];
      xbc_conv8(p, layer, row0 + r, tb0 + r, 768 + 128 * grp + ch * 8, o);
      st128(Cs + r * 272 + ch * 16, __builtin_bit_cast(u32x4, pack8(o)));
      xbc_conv8(p, layer, row0 + r, tb0 + r, 512 + 128 * grp + ch * 8, o);
      st128(Bs + r * 272 + ch * 16, __builtin_bit_cast(u32x4, pack8(o)));
    }
    __syncthreads();
    bf16x8 cf[4];
#pragma unroll
    for (int ks = 0; ks < 4; ++ks) cf[ks] = ld128(Cs + lq * 272 + (32 * ks + 8 * g) * 2);
    f32x4 sT[4];
#pragma unroll
    for (int sf = 0; sf < 4; ++sf) {
      sT[sf] = (f32x4){0.f, 0.f, 0.f, 0.f};
#pragma unroll
      for (int ks = 0; ks < 4; ++ks) sT[sf] = mfma16(ld128(Bs + (16 * sf + i) * 272 + (32 * ks + 8 * g) * 2), cf[ks], sT[sf]);
    }
#pragma unroll 1
    for (int hh = 0; hh < 4; ++hh) {
      const int hd = 4 * grp + hh;
      __syncthreads();
      {
        const bf16_t* st = p.states + (((long)b * 128 + c) * 8 + hd) * 8192;
        for (int it = 0; it < 4; ++it) {
          int r = (tid >> 4) + 16 * it, ch = tid & 15;
          st128(Bs + r * 272 + ch * 16, gld128(st + r * 128 + ch * 8));
        }
        for (int it = 0; it < 2; ++it) {
          int r = (tid >> 3) + 32 * it, ch = tid & 7;
          float o[8];
          xbc_conv8(p, layer, row0 + r, tb0 + r, hd * 64 + ch * 8, o);
          st128(Xh + r * 144 + ch * 16, __builtin_bit_cast(u32x4, pack8(o)));
        }
      }
      __syncthreads();
      f32x4 acc[4];
#pragma unroll
      for (int pf = 0; pf < 4; ++pf) {
        acc[pf] = (f32x4){0.f, 0.f, 0.f, 0.f};
#pragma unroll
        for (int ks = 0; ks < 4; ++ks) acc[pf] = mfma16(ld128(Bs + (16 * pf + i) * 272 + (32 * ks + 8 * g) * 2), cf[ks], acc[pf]);
      }
      const float al = ldsf(acs + hh * 256 + lq * 4);
      const float el = __expf(al);
#pragma unroll
      for (int pf = 0; pf < 4; ++pf) acc[pf] *= el;
      const float Dh = p.ssd_d[layer * 8 + hd];
      f32x4 pt[4];
#pragma unroll
      for (int sf = 0; sf < 4; ++sf)
#pragma unroll
        for (int r = 0; r < 4; ++r) {
          int s = 16 * sf + 4 * g + r;
          float v = 0.f;
          if (s <= lq) v = sT[sf][r] * ldsf(dts + hh * 256 + s * 4) * __expf(al - ldsf(acs + hh * 256 + s * 4));
          if (s == lq) v += Dh;
          pt[sf][r] = v;
        }
#pragma unroll
      for (int ks = 0; ks < 2; ++ks) {
        bf16x8 pb = pack44(pt[2 * ks], pt[2 * ks + 1]);
#pragma unroll
        for (int pf = 0; pf < 4; ++pf) {
          ldsp a = Xh + (32 * ks + 4 * g + (i >> 2)) * 144 + (16 * pf + 4 * (i & 3)) * 2;
          acc[pf] = mfma16(cat4(ldtr(a), ldtr(a + 16 * 144)), pb, acc[pf]);
        }
      }
#pragma unroll
      for (int pf = 0; pf < 4; ++pf) {
        int col = hd * 64 + 16 * pf + 4 * g;
        u32x2 zz = *(const u32x2*)(p.proj + (row0 + lq) * NP + C_Z + col);
        float z0 = bflo(zz.x), z1 = bfhi(zz.x), z2 = bflo(zz.y), z3 = bfhi(zz.y);
        f32x4 y;
        y[0] = acc[pf][0] * siluf(z0); y[1] = acc[pf][1] * siluf(z1);
        y[2] = acc[pf][2] * siluf(z2); y[3] = acc[pf][3] * siluf(z3);
        ssq += y[0] * y[0] + y[1] * y[1] + y[2] * y[2] + y[3] * y[3];
        { u32x2 yp; yp.x = pk2(y[0], y[1]); yp.y = pk2(y[2], y[3]); *(u32x2*)(p.ymix + slab_idx(row0 + lq, col, NTOK)) = yp; }
      }
    }
  }
  ssq += __shfl_xor(ssq, 16);
  ssq += __shfl_xor(ssq, 32);
  const float rstd = rsqrtf(ssq * (1.f / 512.f) + 1e-6f);
  const float* nw = p.ssd_norm_w + layer * 512;
#pragma unroll 1
  for (int q = 0; q < 32; ++q) {
    int col = (q >> 2) * 64 + 16 * (q & 3) + 4 * g;
    float4 w4 = *(const float4*)(nw + col);
    u32x2* yp_ = (u32x2*)(p.ymix + slab_idx(row0 + lq, col, NTOK));
    u32x2 yp = *yp_;
    u32x2 o;
    o.x = pk2(bflo(yp.x) * rstd * w4.x, bfhi(yp.x) * rstd * w4.y);
    o.y = pk2(bflo(yp.y) * rstd * w4.z, bfhi(yp.y) * rstd * w4.w);
    *yp_ = o;
  }
}

template <int NH>
__device__ __forceinline__ void qk_tile(f32x4 (&s)[4][NH], ldsp Ks, const bf16x8 (&qf)[NH][2], int i, int g) {
#pragma unroll
  for (int kf = 0; kf < 4; ++kf)
#pragma unroll
    for (int h = 0; h < NH; ++h) s[kf][h] = (f32x4){0.f, 0.f, 0.f, 0.f};
  __builtin_amdgcn_s_setprio(1);
#pragma unroll
  for (int ks = 0; ks < 2; ++ks)
#pragma unroll
    for (int kf = 0; kf < 4; ++kf) {
      bf16x8 a = ld128(Ks + (16 * kf + i) * 144 + (32 * ks + 8 * g) * 2);
#pragma unroll
      for (int h = 0; h < NH; ++h) s[kf][h] = mfma16(a, qf[h][ks], s[kf][h]);
    }
  __builtin_amdgcn_s_setprio(0);
}
__device__ __forceinline__ void pv_tile(f32x4 (&o)[4][2], ldsp Vs, const f32x4 (&s)[4][2], int i, int g) {
  __builtin_amdgcn_s_setprio(1);
#pragma unroll
  for (int ks = 0; ks < 2; ++ks) {
    bf16x8 pb[2];
#pragma unroll
    for (int h = 0; h < 2; ++h) pb[h] = pack44_rtz(s[2 * ks][h], s[2 * ks + 1][h]);
#pragma unroll
    for (int df = 0; df < 4; ++df) {
      ldsp a = Vs + (32 * ks + 4 * g + (i >> 2)) * 144 + (16 * df + 4 * (i & 3)) * 2;
      bf16x8 av = cat4(ldtr(a), ldtr(a + 16 * 144));
#pragma unroll
      for (int h = 0; h < 2; ++h) o[df][h] = mfma16(av, pb[h], o[df][h]);
    }
  }
  __builtin_amdgcn_s_setprio(0);
}
__device__ __forceinline__ void stage64_ld(u32x4 (&r)[2], const bf16_t* src, long stride) {
  const int tid = tidx();
#pragma unroll
  for (int it = 0; it < 2; ++it) r[it] = gld128(src + (long)((tid >> 3) + 32 * it) * stride + (tid & 7) * 8);
}
__device__ __forceinline__ void stage64_st(const u32x4 (&r)[2], ldsp dst) {
  const int tid = tidx();
#pragma unroll
  for (int it = 0; it < 2; ++it) st128(dst + ((tid >> 3) + 32 * it) * 144 + (tid & 7) * 16, r[it]);
}

__device__ __forceinline__ void osm_update(f32x4 (&s)[4][2], const bool (&vm)[4][4], float (&m)[2], float (&l)[2], f32x4 (&o)[4][2]) {
#pragma unroll
  for (int h = 0; h < 2; ++h) {
    float tmax = -1e30f;
#pragma unroll
    for (int kf = 0; kf < 4; ++kf)
#pragma unroll
      for (int r = 0; r < 4; ++r) {
        float v = vm[kf][r] ? s[kf][h][r] : -1e30f;
        tmax = fmaxf(tmax, v);
      }
    tmax = fmaxf(tmax, __shfl_xor(tmax, 16));
    tmax = fmaxf(tmax, __shfl_xor(tmax, 32));
    float mnew = fmaxf(m[h], tmax);
    float alpha = ex2(m[h] - mnew);
    m[h] = mnew;
    float ps = 0.f;
#pragma unroll
    for (int kf = 0; kf < 4; ++kf)
#pragma unroll
      for (int r = 0; r < 4; ++r) {
        float pv = vm[kf][r] ? ex2(s[kf][h][r] - mnew) : 0.f;
        s[kf][h][r] = pv;
        ps += pv;
      }
    l[h] = l[h] * alpha + ps;
#pragma unroll
    for (int df = 0; df < 4; ++df) o[df][h] *= alpha;
  }
}

template <bool LANEMASK>
__device__ __forceinline__ void osm_update_full(f32x4 (&s)[4][2], bool lv, float (&m)[2], float (&l)[2], f32x4 (&o)[4][2]) {
#pragma unroll
  for (int h = 0; h < 2; ++h) {
    float tmax = s[0][h][0];
#pragma unroll
    for (int kf = 0; kf < 4; ++kf)
#pragma unroll
      for (int r = 0; r < 4; ++r) tmax = fmaxf(tmax, s[kf][h][r]);
    if (LANEMASK) tmax = lv ? tmax : -1e30f;
    tmax = fmaxf(tmax, __shfl_xor(tmax, 16));
    tmax = fmaxf(tmax, __shfl_xor(tmax, 32));
    float mnew = fmaxf(m[h], tmax);
    float alpha = ex2(m[h] - mnew);
    m[h] = mnew;
    float ps = 0.f;
#pragma unroll
    for (int kf = 0; kf < 4; ++kf)
#pragma unroll
      for (int r = 0; r < 4; ++r) {
        float pv = ex2(s[kf][h][r] - mnew);
        if (LANEMASK) pv = lv ? pv : 0.f;
        s[kf][h][r] = pv;
        ps += pv;
      }
    l[h] = l[h] * alpha + ps;
#pragma unroll
    for (int df = 0; df < 4; ++df) o[df][h] *= alpha;
  }
}

__device__ __forceinline__ void nsa_item(const P& p, int layer, int item, ldsp smem) {
  asm volatile("" : "+s"(layer));
  const int tid = tidx(), lane = tid & 63, w = tid >> 6, i = lane & 15, g = lane >> 4;
  const int sub = item & 7, b = sub >> 1, hp = sub & 1;
  const int rnk = (item & 511) >> 3;
  const int qt = item < 512 ? 127 - rnk : rnk;
  const int t0 = qt * 64;
  const int tl = t0 + 16 * w + i;
  const long rowl = (long)b * SEQ + tl;
  const long rowb = (long)b * SEQ;
  ldsp Ks = smem, Vs = smem + 9216, imp = smem + 18432, selm = smem + 52224, uni = smem + 53248, lst = smem + 53280;
  const bf16_t* kc = p.kcvc + (long)b * 512 * 64;
  const bf16_t* vc = p.kcvc + (long)2048 * 64 + (long)b * 512 * 64;
  __syncthreads();
  for (int e = tid; e < 64 * 132; e += 256) stsf(imp + e * 4, 0.f);
  const int nhi = (t0 + 32) >> 4;
  const int ncmp = (nhi > 510 ? 510 : nhi) / 64 + 1;
  float m4[4], inv4[4];
  {
    bf16x8 qf[4][2];
#pragma unroll
    for (int h = 0; h < 4; ++h)
#pragma unroll
      for (int ks = 0; ks < 2; ++ks)
        qf[h][ks] = __builtin_bit_cast(bf16x8, gld128(p.proj + rowl * NP + C_Q + h * 64 + 32 * ks + 8 * g));
    float l4[4];
#pragma unroll
    for (int h = 0; h < 4; ++h) { m4[h] = -1e30f; l4[h] = 0.f; }
    {
      u32x4 kr[2];
      stage64_ld(kr, kc, 64);
      for (int kt = 0; kt < ncmp; ++kt) {
        __syncthreads();
        stage64_st(kr, Ks);
        __syncthreads();
        if (kt + 1 < ncmp) stage64_ld(kr, kc + (long)(kt + 1) * 64 * 64, 64);
        f32x4 s[4][4];
        qk_tile<4>(s, Ks, qf, i, g);
        const bool cfull = ((kt * 64 + 63) * 16 + 31 <= t0) && (kt * 64 + 63 < 511);
        if (cfull) {
#pragma unroll
          for (int h = 0; h < 4; ++h) {
            float tmax = s[0][h][0];
#pragma unroll
            for (int kf = 0; kf < 4; ++kf)
#pragma unroll
              for (int r = 0; r < 4; ++r) tmax = fmaxf(tmax, s[kf][h][r]);
            tmax = fmaxf(tmax, __shfl_xor(tmax, 16));
            tmax = fmaxf(tmax, __shfl_xor(tmax, 32));
            float mnew = fmaxf(m4[h], tmax);
            float ps = 0.f;
#pragma unroll
            for (int kf = 0; kf < 4; ++kf)
#pragma unroll
              for (int r = 0; r < 4; ++r) ps += ex2(s[kf][h][r] - mnew);
            l4[h] = l4[h] * ex2(m4[h] - mnew) + ps;
            m4[h] = mnew;
          }
        } else {
#pragma unroll
        for (int h = 0; h < 4; ++h) {
          float tmax = -1e30f;
#pragma unroll
          for (int kf = 0; kf < 4; ++kf)
#pragma unroll
            for (int r = 0; r < 4; ++r) {
              int key = kt * 64 + 16 * kf + 4 * g + r;
              bool ok = (key * 16 + 31 <= tl) && key < 511;
              float v = ok ? s[kf][h][r] : -1e30f;
              s[kf][h][r] = v;
              tmax = fmaxf(tmax, v);
            }
          tmax = fmaxf(tmax, __shfl_xor(tmax, 16));
          tmax = fmaxf(tmax, __shfl_xor(tmax, 32));
          float mnew = fmaxf(m4[h], tmax);
          float ps = 0.f;
#pragma unroll
          for (int kf = 0; kf < 4; ++kf)
#pragma unroll
            for (int r = 0; r < 4; ++r) ps += (s[kf][h][r] > -1e29f) ? ex2(s[kf][h][r] - mnew) : 0.f;
          l4[h] = l4[h] * ex2(m4[h] - mnew) + ps;
          m4[h] = mnew;
        }
        }
      }
    }
#pragma unroll
    for (int h = 0; h < 4; ++h) {
      float lt = l4[h];
      lt += __shfl_xor(lt, 16);
      lt += __shfl_xor(lt, 32);
      inv4[h] = 1.f / fmaxf(lt, 1e-20f);
    }
    {
      u32x4 kr[2];
      stage64_ld(kr, kc, 64);
      for (int kt = 0; kt < ncmp; ++kt) {
        __syncthreads();
        stage64_st(kr, Ks);
        __syncthreads();
        if (kt + 1 < ncmp) stage64_ld(kr, kc + (long)(kt + 1) * 64 * 64, 64);
        f32x4 s[4][4];
        qk_tile<4>(s, Ks, qf, i, g);
        const bool cfull2 = ((kt * 64 + 63) * 16 + 31 <= t0) && (kt * 64 + 63 < 511);
        float mainv[4], spill[4];
#pragma unroll
        for (int kf = 0; kf < 4; ++kf) {
          mainv[kf] = 0.f; spill[kf] = 0.f;
#pragma unroll
          for (int r = 0; r < 4; ++r) {
            float pr = 0.f;
            if (cfull2) {
#pragma unroll
              for (int h = 0; h < 4; ++h) pr += ex2(s[kf][h][r] - m4[h]) * inv4[h];
            } else {
              int key = kt * 64 + 16 * kf + 4 * g + r;
              bool ok = (key * 16 + 31 <= tl) && key < 511;
#pragma unroll
              for (int h = 0; h < 4; ++h) pr += ok ? ex2(s[kf][h][r] - m4[h]) * inv4[h] : 0.f;
            }
            mainv[kf] += pr;
            if (r == 3) spill[kf] = pr;
          }
        }
        ldsp ir = imp + (16 * w + i) * 528;
#pragma unroll
        for (int kf = 0; kf < 4; ++kf) {
          int blk = 16 * kt + 4 * kf + g;
          stsf(ir + blk * 4, ldsf(ir + blk * 4) + mainv[kf]);
        }
#pragma unroll
        for (int kf = 0; kf < 4; ++kf) {
          int blk = 16 * kt + 4 * kf + g + 1;
          stsf(ir + blk * 4, ldsf(ir + blk * 4) + spill[kf]);
        }
      }
    }
  }
  __syncthreads();
  {
    int tok = tid >> 2, sb = tid & 3;
    unsigned mask = 0;
    const int cur = qt;
    ldsp ir = imp + tok * 528;
    if (cur < 16) {
      for (int j = 32 * sb; j < 32 * sb + 32; ++j)
        if (j <= cur) mask |= 1u << (j & 31);
    } else {
      float v[32];
#pragma unroll
      for (int q4 = 0; q4 < 8; ++q4) {
        f32x4 vv = *(LAS const f32x4*)(ir + (32 * sb + 4 * q4) * 4);
#pragma unroll
        for (int e = 0; e < 4; ++e) {
          int j = 32 * sb + 4 * q4 + e;
          v[4 * q4 + e] = (j >= 1 && j <= cur - 2) ? vv[e] : -INFINITY;
          if (j == 0 || (j > cur - 2 && j <= cur)) mask |= 1u << (j & 31);
        }
      }
#pragma unroll 1
      for (int round = 0; round < 13; ++round) {
        float bv = -INFINITY; int be = 0;
#pragma unroll
        for (int e = 0; e < 32; ++e) { bool gt_ = v[e] > bv; bv = gt_ ? v[e] : bv; be = gt_ ? e : be; }
        int bj = 32 * sb + be;
#pragma unroll
        for (int o = 1; o <= 2; o <<= 1) {
          float ov = __shfl_xor(bv, o); int oj = __shfl_xor(bj, o);
          bool take = (ov > bv) || (ov == bv && oj < bj);
          bv = take ? ov : bv; bj = take ? oj : bj;
        }
        if ((bj >> 5) == sb) {
          int e0 = bj & 31;
          mask |= 1u << e0;
#pragma unroll
          for (int e = 0; e < 32; ++e) v[e] = (e == e0) ? -INFINITY : v[e];
        }
      }
    }
    stsu(selm + (tok * 4 + sb) * 4, mask);
  }
  __syncthreads();
  if (w == 0) {
    unsigned a0 = ldsu(selm + (lane * 4 + 0) * 4), a1 = ldsu(selm + (lane * 4 + 1) * 4), a2 = ldsu(selm + (lane * 4 + 2) * 4), a3 = ldsu(selm + (lane * 4 + 3) * 4);
#pragma unroll
    for (int o = 32; o >= 1; o >>= 1) { a0 |= __shfl_xor(a0, o); a1 |= __shfl_xor(a1, o); a2 |= __shfl_xor(a2, o); a3 |= __shfl_xor(a3, o); }
    if (lane == 0) { stsu(uni, a0); stsu(uni + 4, a1); stsu(uni + 8, a2); stsu(uni + 12, a3); }
  }
  __syncthreads();
  if (tid < 128) {
    const unsigned u0 = ldsu(uni), u1 = ldsu(uni + 4), u2 = ldsu(uni + 8), u3 = ldsu(uni + 12);
    const int wd = tid >> 5, bp = tid & 31;
    const unsigned uw = wd == 0 ? u0 : (wd == 1 ? u1 : (wd == 2 ? u2 : u3));
    const int pos = (wd > 0 ? __popc(u0) : 0) + (wd > 1 ? __popc(u1) : 0) + (wd > 2 ? __popc(u2) : 0) + __popc(uw & ((1u << bp) - 1u));
    if ((uw >> bp) & 1u) stsu(lst + 4 + pos * 4, (unsigned)tid);
    if (tid == 0) stsu(lst, (unsigned)(__popc(u0) + __popc(u1) + __popc(u2) + __popc(u3)));
  }
  __syncthreads();
  const int nsel = __builtin_amdgcn_readfirstlane((int)ldsu(lst));
  unsigned mysel[4];
#pragma unroll
  for (int q = 0; q < 4; ++q) mysel[q] = ldsu(selm + ((16 * w + i) * 4 + q) * 4);
  {
    bf16x8 qf[2][2];
    float gt[2][3];
#pragma unroll
    for (int h = 0; h < 2; ++h) {
#pragma unroll
      for (int ks = 0; ks < 2; ++ks)
        qf[h][ks] = __builtin_bit_cast(bf16x8, gld128(p.proj + rowl * NP + C_Q + (2 * hp + h) * 64 + 32 * ks + 8 * g));
#pragma unroll
      for (int br = 0; br < 3; ++br) gt[h][br] = sigmf(bf2f(p.proj[rowl * NP + C_G + 3 * (2 * hp + h) + br]));
    }
    float mh[2], ih[2];
    mh[0] = hp ? m4[2] : m4[0]; mh[1] = hp ? m4[3] : m4[1];
    ih[0] = hp ? inv4[2] : inv4[0]; ih[1] = hp ? inv4[3] : inv4[1];
    f32x4 out[4][2];
#pragma unroll
    for (int df = 0; df < 4; ++df)
#pragma unroll
      for (int h = 0; h < 2; ++h) out[df][h] = (f32x4){0.f, 0.f, 0.f, 0.f};
    {
      u32x4 kr[2], vr[2];
      stage64_ld(kr, kc, 64);
      stage64_ld(vr, vc, 64);
      for (int kt = 0; kt < ncmp; ++kt) {
        __syncthreads();
        stage64_st(kr, Ks);
        stage64_st(vr, Vs);
        __syncthreads();
        if (kt + 1 < ncmp) {
          stage64_ld(kr, kc + (long)(kt + 1) * 64 * 64, 64);
          stage64_ld(vr, vc + (long)(kt + 1) * 64 * 64, 64);
        }
        f32x4 s[4][2];
        qk_tile<2>(s, Ks, qf, i, g);
        const bool cfull3 = ((kt * 64 + 63) * 16 + 31 <= t0) && (kt * 64 + 63 < 511);
        const float cg0 = ih[0] * gt[0][0], cg1 = ih[1] * gt[1][0];
#pragma unroll
        for (int kf = 0; kf < 4; ++kf)
#pragma unroll
          for (int r = 0; r < 4; ++r) {
            if (cfull3) {
              s[kf][0][r] = ex2(s[kf][0][r] - mh[0]) * cg0;
              s[kf][1][r] = ex2(s[kf][1][r] - mh[1]) * cg1;
            } else {
              int key = kt * 64 + 16 * kf + 4 * g + r;
              bool ok = (key * 16 + 31 <= tl) && key < 511;
              s[kf][0][r] = ok ? ex2(s[kf][0][r] - mh[0]) * cg0 : 0.f;
              s[kf][1][r] = ok ? ex2(s[kf][1][r] - mh[1]) * cg1 : 0.f;
            }
          }
        pv_tile(out, Vs, s, i, g);
      }
    }
#pragma unroll 1
    for (int br = 1; br < 3; ++br) {
      f32x4 o[4][2];
      float m[2], l[2];
#pragma unroll
      for (int h = 0; h < 2; ++h) {
        m[h] = -1e30f; l[h] = 0.f;
#pragma unroll
        for (int df = 0; df < 4; ++df) o[df][h] = (f32x4){0.f, 0.f, 0.f, 0.f};
      }
      const int jw0 = t0 >= 512 ? 0 : (512 - t0) >> 6;
      const int ntile = br == 1 ? nsel : 9 - jw0;
      const int kcol = br == 1 ? C_KS : C_KW, vcol = br == 1 ? C_VS : C_VW;
      auto tile_tok = [&](int idx) -> int {
        if (br == 1) return 64 * __builtin_amdgcn_readfirstlane((int)ldsu(lst + 4 + idx * 4));
        return t0 - 512 + 64 * (jw0 + idx);
      };
      u32x4 kr[2], vr[2];
      int ktn = tile_tok(0);
      stage64_ld(kr, p.proj + (rowb + ktn) * NP + kcol, NP);
      stage64_ld(vr, p.proj + (rowb + ktn) * NP + vcol, NP);
      for (int idx = 0; idx < ntile; ++idx) {
        const int kt0 = ktn;
        __syncthreads();
        stage64_st(kr, Ks);
        stage64_st(vr, Vs);
        __syncthreads();
        if (idx + 1 < ntile) {
          ktn = tile_tok(idx + 1);
          stage64_ld(kr, p.proj + (rowb + ktn) * NP + kcol, NP);
          stage64_ld(vr, p.proj + (rowb + ktn) * NP + vcol, NP);
        }
        bool selbit = true;
        if (br == 1) {
          int j = kt0 >> 6;
          unsigned mw = j < 32 ? mysel[0] : (j < 64 ? mysel[1] : (j < 96 ? mysel[2] : mysel[3]));
          selbit = (mw >> (j & 31)) & 1u;
        }
        if (br == 1 && !__any(selbit)) continue;
        f32x4 s[4][2];
        qk_tile<2>(s, Ks, qf, i, g);
        const bool full = (kt0 + 63 <= t0) && (br == 1 || kt0 >= t0 - 448);
        if (full) {
          if (br == 1) osm_update_full<true>(s, selbit, m, l, o);
          else osm_update_full<false>(s, true, m, l, o);
        } else {
          bool vm[4][4];
#pragma unroll
          for (int kf = 0; kf < 4; ++kf)
#pragma unroll
            for (int r = 0; r < 4; ++r) {
              int ktok = kt0 + 16 * kf + 4 * g + r;
              vm[kf][r] = br == 1 ? (selbit && ktok <= tl) : (ktok <= tl && ktok > tl - 512);
            }
          osm_update(s, vm, m, l, o);
        }
        pv_tile(o, Vs, s, i, g);
      }
#pragma unroll
      for (int h = 0; h < 2; ++h) {
        float lt = l[h];
        lt += __shfl_xor(lt, 16);
        lt += __shfl_xor(lt, 32);
        float cc = (br == 1 ? gt[h][1] : gt[h][2]) / fmaxf(lt, 1e-20f);
#pragma unroll
        for (int df = 0; df < 4; ++df) out[df][h] += o[df][h] * cc;
      }
    }
#pragma unroll
    for (int h = 0; h < 2; ++h)
#pragma unroll
      for (int df = 0; df < 4; ++df) {
        u32x2 ov;
        ov.x = pk2(out[df][h][0], out[df][h][1]);
        ov.y = pk2(out[df][h][2], out[df][h][3]);
        *(u32x2*)(p.ymix + slab_idx(rowl, 768 + (2 * hp + h) * 64 + 16 * df + 4 * g, NTOK)) = ov;
      }
  }
}

#define XB_TMO      128
#define XB_XCNT(j)  (256  + 64 * (j))
#define XB_XSUB(j)  (1280 + 64 * (j))
#define XB_XGEN(j)  (2304 + 64 * (j))
#define XB_TOP      3328
#define XB_TOPGEN   3392
#define XCD_BAR_WORDS 3456
#define XB_SPIN_CAP (1u << 22)
__device__ __forceinline__ unsigned xb_ld(unsigned* p) { return __hip_atomic_load(p, __ATOMIC_RELAXED, __HIP_MEMORY_SCOPE_AGENT); }
__device__ __forceinline__ unsigned xb_add(unsigned* p, unsigned v) { return __hip_atomic_fetch_add(p, v, __ATOMIC_RELAXED, __HIP_MEMORY_SCOPE_AGENT); }
__device__ __forceinline__ unsigned xb_xcc_id() { return (unsigned)__builtin_amdgcn_s_getreg((3 << 11) | 20) & 0xFu; }
#define XB_SPIN(cond, bar) do { unsigned _sp = 0; while (cond) { __builtin_amdgcn_s_sleep(1); \
    if ((++_sp & 255u) == 0u) { if (xb_ld(&(bar)[XB_TMO])) break; if (_sp > XB_SPIN_CAP) { atomicAdd(&(bar)[XB_TMO], 1u); break; } } } } while (0)
struct XcdBarrier { unsigned* bar; unsigned x; volatile LAS unsigned* st; };
__device__ __forceinline__ XcdBarrier xcd_barrier_post(unsigned* bar, volatile LAS unsigned* st) {
  XcdBarrier b; b.bar = bar; b.x = xb_xcc_id(); b.st = st;
  if (threadIdx.x == 0) (void)xb_add(&bar[XB_XCNT(b.x)], 1u);
  return b;
}
__device__ __forceinline__ void xcd_barrier_complete(unsigned* bar, unsigned x, unsigned& nloc, unsigned& nx) {
  const unsigned G = gridDim.x * gridDim.y * gridDim.z;
  unsigned sum, cnt, mine, sp = 0u;
  for (;;) {
    sum = 0u; cnt = 0u; mine = 0u;
#pragma unroll
    for (unsigned j = 0; j < 16; ++j) { const unsigned c = xb_ld(&bar[XB_XCNT(j)]); sum += c; cnt += (c > 0u) ? 1u : 0u; mine = (j == x) ? c : mine; }
    if (sum == G) break;
    __builtin_amdgcn_s_sleep(1);
    if ((++sp & 255u) == 0u) { if (xb_ld(&bar[XB_TMO])) break; if (sp > XB_SPIN_CAP) { atomicAdd(&bar[XB_TMO], 1u); break; } }
  }
  nloc = mine > 0u ? mine : 1u; nx = cnt > 0u ? cnt : 1u;
}
__device__ __forceinline__ void xcd_barrier(const XcdBarrier& b) {
  asm volatile("s_waitcnt vmcnt(0)" ::: "memory");
  __syncthreads();
  if (threadIdx.x == 0) {
    unsigned* bar = b.bar;
    __builtin_amdgcn_s_waitcnt(0);
    unsigned nloc = b.st[0], nx = b.st[1];
    if (nloc == 0u) { xcd_barrier_complete(bar, b.x, nloc, nx); b.st[0] = nloc; b.st[1] = nx; }
    const unsigned old = xb_add(&bar[XB_XSUB(b.x)], 1u);
    const unsigned gen = old / nloc;
    if (old + 1u == (gen + 1u) * nloc) {
      __builtin_amdgcn_fence(__ATOMIC_RELEASE, "agent");
      asm volatile("s_waitcnt vmcnt(0)" ::: "memory");
      const unsigned og = xb_add(&bar[XB_TOP], 1u);
      const unsigned tg = og / nx;
      if (og + 1u == (tg + 1u) * nx) xb_add(&bar[XB_TOPGEN], 1u);
      else XB_SPIN(xb_ld(&bar[XB_TOPGEN]) == tg, bar);
      __builtin_amdgcn_fence(__ATOMIC_ACQUIRE, "agent");
      xb_add(&bar[XB_XGEN(b.x)], 1u);
      asm volatile("s_waitcnt vmcnt(0)" ::: "memory");
    } else {
      XB_SPIN(xb_ld(&bar[XB_XGEN(b.x)]) == gen, bar);
      __builtin_amdgcn_fence(__ATOMIC_ACQUIRE, "agent");
      asm volatile("s_waitcnt vmcnt(0)" ::: "memory");
    }
  }
  __syncthreads();
}

enum { PH_CONV = 0, PH_INPROJ, PH_MIX1, PH_MIX2, PH_MIX3, PH_OUTPROJ, PH_UP, PH_DOWN, PH_FINAL };

__device__ __forceinline__ void run_phase(const P& p, int ph, int layer, ldsp smem) {
  switch (ph) {
    case PH_CONV: ph_convert(p, smem); ph_prepass(p); break;
    case PH_INPROJ: ph_inproj(p, layer, smem); break;
    case PH_MIX1:
      if (gridDim.x > 64) {
        if (blockIdx.x < 32) cmp_gemm1_tile(p, layer, blockIdx.x, smem);
        else for (int it = blockIdx.x - 32; it < 1024; it += gridDim.x - 32) ssd1_item(p, layer, it, smem);
      } else {
        for (int it = blockIdx.x; it < 32; it += gridDim.x) cmp_gemm1_tile(p, layer, it, smem);
        for (int it = blockIdx.x; it < 1024; it += gridDim.x) ssd1_item(p, layer, it, smem);
      }
      for (int it = blockIdx.x; it < 512; it += gridDim.x) shortconv_item(p, layer, it);
      break;
    case PH_MIX2:
      for (int it = blockIdx.x; it < 512; it += gridDim.x) ssd2_item(p, it);
      for (int it = blockIdx.x; it < 1024; it += gridDim.x) cmp_gemm2_item(p, layer, it);
      break;
    case PH_MIX3:
      for (int it = blockIdx.x; it < 1024; it += gridDim.x) nsa_item(p, layer, it, smem);
      for (int it = blockIdx.x; it < 512; it += gridDim.x) ssd3_item(p, layer, it, smem);
      break;
    case PH_OUTPROJ: ph_resgemm(p.ymix, DM, p.WoutT + (long)layer * DM * DM, p.h, p.ssqp, smem); break;
    case PH_UP: ph_ffn_up(p, layer, smem); break;
    case PH_DOWN: ph_resgemm(p.act, DFF, p.WdownT + (long)layer * DM * DFF, p.h, p.ssqp, smem); break;
    case PH_FINAL: ph_final(p); break;
  }
}

#if SINGLE_LAUNCH
__global__ void __launch_bounds__(256, 2) k_all(P p) {
  extern __shared__ __attribute__((aligned(16))) unsigned char lds_raw[];
  ldsp smem = (ldsp)lds_raw;
  cg::grid_group grid = cg::this_grid();
  volatile LAS unsigned* st = (volatile LAS unsigned*)(smem + LDS_MAIN);
  if (threadIdx.x < 4) st[threadIdx.x] = 0u;
  __syncthreads();
  XcdBarrier xb = xcd_barrier_post(p.bar, st);
  constexpr int NSTEP = 2 + NLAYER * 7;
  for (int step = 0; step < NSTEP; ++step) {
    int ph, layer;
    if (step == 0) { ph = PH_CONV; layer = 0; }
    else if (step == NSTEP - 1) { ph = PH_FINAL; layer = 0; }
    else { layer = (step - 1) / 7; ph = PH_INPROJ + (step - 1) % 7; }
    const int reps = (ph == REP_PH) ? 2 : 1;
    for (int r = 0; r < reps; ++r) run_phase(p, ph, layer, smem);
    if (step == 0) grid.sync();
    else if (step + 1 < NSTEP) xcd_barrier(xb);
  }
}
#define KMAIN k_all
#else
__global__ void __launch_bounds__(256, 2) k_phase(P p, int ph, int layer) {
  extern __shared__ __attribute__((aligned(16))) unsigned char lds_raw[];
  run_phase(p, ph, layer, (ldsp)lds_raw);
}
#define KMAIN k_phase
#endif

extern "C" void kernel_launch(void* const* d_in, const int* in_sizes, int n_in, void* d_out, int out_size, void* d_ws,
                              size_t ws_size, hipStream_t stream) {
  static int grid_blocks = 0;
  if (!grid_blocks) {
    int dev = 0, cus = 0, per_cu = 0;
    (void)hipGetDevice(&dev);
    (void)hipDeviceGetAttribute(&cus, hipDeviceAttributeMultiprocessorCount, dev);
    (void)hipFuncSetAttribute((const void*)KMAIN, hipFuncAttributeMaxDynamicSharedMemorySize, LDS_BYTES);
    (void)hipOccupancyMaxActiveBlocksPerMultiprocessor(&per_cu, (const void*)KMAIN, 256, LDS_BYTES);
    if (per_cu < 1) per_cu = 1;
    if (per_cu > 2) per_cu = 2;
    grid_blocks = cus * per_cu;
  }
  P p{};
  const float** pin = (const float**)&p;
  for (int q = 0; q < 23; ++q) pin[q] = (const float*)d_in[q];
  p.out = (float*)d_out;
  unsigned char* ws = (unsigned char*)d_ws;
  size_t off = 0;
  auto take = [&](size_t bytes) { unsigned char* r = ws + off; off += (bytes + 255) & ~(size_t)255; return r; };
  p.WinT = (bf16_t*)take((size_t)NLAYER * NP * DM * 2);
  p.WoutT = (bf16_t*)take((size_t)NLAYER * DM * DM * 2);
  p.WupT = (bf16_t*)take((size_t)NLAYER * 5632 * DM * 2);
  p.WdownT = (bf16_t*)take((size_t)NLAYER * DM * DFF * 2);
  p.W1T = (bf16_t*)take((size_t)NLAYER * 2 * 128 * 2048 * 2);
  p.zeros = (bf16_t*)take(4096);
  p.cwh = (bf16_t*)take((size_t)NLAYER * 5 * 1024 * 2);
  p.c1 = (float*)take(NLAYER * 2 * 128 * 4);
  p.rope = (float*)take((size_t)SEQ * 64 * 4);
  p.cdec = (float*)take(4 * 128 * 8 * 4);
  p.bar = (unsigned*)take(XCD_BAR_WORDS * 4);
  p.ssqp = (float*)take((size_t)NTOK * 8 * 4);
  p.hid = (bf16_t*)take((size_t)2 * 2048 * 128 * 2);
  p.kcvc = (bf16_t*)take((size_t)2 * 2048 * 64 * 2);
  p.h = (bf16_t*)take((size_t)NTOK * DM * 2);
  p.states = (bf16_t*)take((size_t)NTOK * DM * 2);
  p.proj = (bf16_t*)take((size_t)NTOK * NP * 2);
  p.act = p.proj;
  p.ymix = (bf16_t*)take((size_t)NTOK * DM * 2);
  if (off > ws_size) { fprintf(stderr, "workspace too small: need %zu have %zu\n", off, ws_size); return; }
#if SINGLE_LAUNCH
  (void)hipMemsetAsync(p.bar, 0, XCD_BAR_WORDS * 4, stream);
  void* args[] = {&p};
  hipError_t e = hipLaunchCooperativeKernel((const void*)k_all, dim3(grid_blocks), dim3(256), args, LDS_BYTES, stream);
  if (e != hipSuccess) fprintf(stderr, "cooperative launch failed: %s (grid %d)\n", hipGetErrorString(e), grid_blocks);
#else
  k_phase<<<grid_blocks, 256, LDS_BYTES, stream>>>(p, PH_CONV, 0);
  for (int layer = 0; layer < NLAYER; ++layer)
    for (int ph = PH_INPROJ; ph <= PH_DOWN; ++ph) k_phase<<<grid_blocks, 256, LDS_BYTES, stream>>>(p, ph, layer);
  k_phase<<<grid_blocks, 256, LDS_BYTES, stream>>>(p, PH_FINAL, 0);
#endif
}
```

```cpp
#include <hip/hip_runtime.h>
#include <hip/hip_cooperative_groups.h>
#include <cstdio>
namespace cg = cooperative_groups;

#ifndef REP_PH
#define REP_PH -1
#endif
#ifndef SINGLE_LAUNCH
#define SINGLE_LAUNCH 1
#endif

typedef unsigned short bf16_t;
typedef short bf16x8 __attribute__((ext_vector_type(8)));
typedef short s16x4 __attribute__((ext_vector_type(4)));
typedef short v4i16_t __attribute__((ext_vector_type(4)));
typedef float f32x4 __attribute__((ext_vector_type(4)));
typedef unsigned u32x4 __attribute__((ext_vector_type(4)));
typedef unsigned u32x2 __attribute__((ext_vector_type(2)));
#define LAS __attribute__((address_space(3)))
typedef LAS unsigned char* ldsp;

constexpr int NTOK = 32768, SEQ = 8192, DM = 1024, NP = 3072, DFF = 2752, NLAYER = 4;
constexpr int LDS_MAIN = 73728;
constexpr int LDS_BYTES = LDS_MAIN + 16;
constexpr int C_Z = 0, C_XBC = 512, C_SCB = 1536, C_SCC = 1792, C_SCH = 2048, C_Q = 2304, C_KC = 2560, C_VC = 2624,
              C_KS = 2688, C_VS = 2752, C_KW = 2816, C_VW = 2880, C_DT = 2944, C_G = 2952;

struct P {
  const float *x, *attn_norm_w, *w_in, *ssd_conv_w, *ssd_conv_b, *ssd_dt_bias, *ssd_a_log, *ssd_d, *ssd_norm_w, *sc_conv_w,
      *cmp_k_pos, *cmp_k_w1, *cmp_k_w2, *cmp_v_pos, *cmp_v_w1, *cmp_v_w2, *w_out, *ffn_norm_w, *ffn_w_up, *ffn_conv_w,
      *ffn_conv_b, *ffn_w_down, *final_norm_w;
  float* out;
  bf16_t *WinT, *WoutT, *WupT, *WdownT, *W1T, *zeros, *h, *proj, *ymix, *act, *states, *hid, *kcvc;
  float *c1, *rope, *cdec, *ssqp;
  unsigned* bar;
  bf16_t* cwh;
};

__device__ __forceinline__ int tidx() { int t = threadIdx.x; asm volatile("" : "+v"(t)); return t; }
typedef _Float16 h16x8 __attribute__((ext_vector_type(8)));
typedef _Float16 h16x2 __attribute__((ext_vector_type(2)));
__device__ __forceinline__ bf16_t f2bf(float f) { _Float16 h = (_Float16)f; return __builtin_bit_cast(unsigned short, h); }
__device__ __forceinline__ float bf2f(bf16_t b) { return (float)__builtin_bit_cast(_Float16, b); }
__device__ __forceinline__ unsigned pk2(float a, float b) { return __builtin_bit_cast(unsigned, __builtin_amdgcn_cvt_pkrtz(a, b)); }
__device__ __forceinline__ h16x2 as_h2(unsigned u) { return __builtin_bit_cast(h16x2, u); }
__device__ __forceinline__ float bflo(unsigned u) { return (float)__builtin_bit_cast(h16x2, u).x; }
__device__ __forceinline__ float bfhi(unsigned u) { return (float)__builtin_bit_cast(h16x2, u).y; }
__device__ __forceinline__ bf16x8 pack8(const float* v) {
  u32x4 u;
  u.x = pk2(v[0], v[1]); u.y = pk2(v[2], v[3]); u.z = pk2(v[4], v[5]); u.w = pk2(v[6], v[7]);
  return __builtin_bit_cast(bf16x8, u);
}
__device__ __forceinline__ bf16x8 pack44(f32x4 a, f32x4 b) {
  u32x4 u;
  u.x = pk2(a[0], a[1]); u.y = pk2(a[2], a[3]); u.z = pk2(b[0], b[1]); u.w = pk2(b[2], b[3]);
  return __builtin_bit_cast(bf16x8, u);
}
__device__ __forceinline__ bf16x8 pack44_rtz(f32x4 a, f32x4 b) {
  u32x4 u;
  u.x = __builtin_bit_cast(unsigned, __builtin_amdgcn_cvt_pkrtz(a[0], a[1])); u.y = __builtin_bit_cast(unsigned, __builtin_amdgcn_cvt_pkrtz(a[2], a[3]));
  u.z = __builtin_bit_cast(unsigned, __builtin_amdgcn_cvt_pkrtz(b[0], b[1])); u.w = __builtin_bit_cast(unsigned, __builtin_amdgcn_cvt_pkrtz(b[2], b[3]));
  return __builtin_bit_cast(bf16x8, u);
}
__device__ __forceinline__ void unpack8(u32x4 u, float* v) {
  v[0] = bflo(u.x); v[1] = bfhi(u.x); v[2] = bflo(u.y); v[3] = bfhi(u.y);
  v[4] = bflo(u.z); v[5] = bfhi(u.z); v[6] = bflo(u.w); v[7] = bfhi(u.w);
}
__device__ __forceinline__ bf16x8 ld128(ldsp p) { return *(LAS const bf16x8*)p; }
__device__ __forceinline__ void st128(ldsp p, u32x4 v) { *(LAS u32x4*)p = v; }
__device__ __forceinline__ s16x4 ldtr(ldsp p) {
  return __builtin_bit_cast(s16x4, __builtin_amdgcn_ds_read_tr16_b64_v4i16((LAS v4i16_t*)p));
}
__device__ __forceinline__ bf16x8 cat4(s16x4 a, s16x4 b) {
  bf16x8 r;
  r[0] = a[0]; r[1] = a[1]; r[2] = a[2]; r[3] = a[3]; r[4] = b[0]; r[5] = b[1]; r[6] = b[2]; r[7] = b[3];
  return r;
}
__device__ __forceinline__ float ldsf(ldsp p) { return *(LAS const float*)p; }
__device__ __forceinline__ unsigned ldsu(ldsp p) { return *(LAS const unsigned*)p; }
__device__ __forceinline__ void stsf(ldsp p, float v) { *(LAS float*)p = v; }
__device__ __forceinline__ void stsu(ldsp p, unsigned v) { *(LAS unsigned*)p = v; }
__device__ __forceinline__ f32x4 mfma16(bf16x8 a, bf16x8 b, f32x4 c) {
  return __builtin_amdgcn_mfma_f32_16x16x32_f16(__builtin_bit_cast(h16x8, a), __builtin_bit_cast(h16x8, b), c, 0, 0, 0);
}
__device__ __forceinline__ float ex2(float x) { return __builtin_amdgcn_exp2f(x); }
__device__ __forceinline__ float siluf(float x) { return x * __builtin_amdgcn_rcpf(1.f + __expf(-x)); }
__device__ __forceinline__ float sigmf(float x) { return __builtin_amdgcn_rcpf(1.f + __expf(-x)); }
__device__ __forceinline__ float softplusf(float x) { return x > 20.f ? x : log1pf(expf(x)); }
__device__ __forceinline__ float geluf(float x) {
  float u = 0.7978845608028654f * (x + 0.044715f * x * x * x);
  return 0.5f * x * (1.f + tanhf(u));
}
__device__ __forceinline__ u32x4 gld128(const bf16_t* p) { return *(const u32x4*)p; }
__device__ __forceinline__ long slab_idx(long row, int col, long nrows) { return ((long)(col >> 5) * nrows + row) * 32 + (col & 31); }

__device__ __forceinline__ int map_win(int n) {
  if (n < 1536) return n;
  if (n < 2944) return n + 8;
  if (n < 2952) return n - 2944 + 1536;
  if (n < 2964) return n;
  return -1;
}
__device__ __forceinline__ int map_wup(int n) {
  int j = n >> 7, r = n & 127;
  if (j >= 43) return -1;
  return r < 64 ? 64 * j + r : DFF + 64 * j + (r - 64);
}
__device__ __forceinline__ void transpose_tile(const float* src, int Nsrc, bf16_t* dst, int Ndst, int n0, int k0, int kind, ldsp smem,
                                               const float* kscale = nullptr) {
  const int tid = tidx();
  __syncthreads();
  {
    int nn = tid & 63;
    int n = n0 + nn;
    int sc = kind == 0 ? n : (kind == 1 ? map_win(n) : map_wup(n));
    for (int it = 0; it < 16; ++it) {
      int k = it * 4 + (tid >> 6);
      float v = sc >= 0 ? src[(long)(k0 + k) * Nsrc + sc] : 0.f;
      if (kscale) v *= kscale[k0 + k];
      stsf(smem + (k * 65 + nn) * 4, v);
    }
  }
  __syncthreads();
  {
    int nn = tid >> 2, kc = (tid & 3) * 16;
    float v[16];
    for (int e = 0; e < 16; ++e) v[e] = ldsf(smem + ((kc + e) * 65 + nn) * 4);
    u32x4 a, b;
    a.x = pk2(v[0], v[1]); a.y = pk2(v[2], v[3]); a.z = pk2(v[4], v[5]); a.w = pk2(v[6], v[7]);
    b.x = pk2(v[8], v[9]); b.y = pk2(v[10], v[11]); b.z = pk2(v[12], v[13]); b.w = pk2(v[14], v[15]);
    bf16_t* d = dst + slab_idx(n0 + nn, k0 + kc, Ndst);
    *(u32x4*)d = a;
    *(u32x4*)(d + 8) = b;
  }
}

constexpr int CV_WIN = 48 * 16, CV_WOUT = 16 * 16, CV_WUP = 88 * 16, CV_WDN = 16 * 43, CV_W1 = 2 * 32;
constexpr int CV_LAYER = CV_WIN + CV_WOUT + CV_WUP + CV_WDN + 2 * CV_W1;
constexpr int CV_ROPE = 1024, CV_C1 = 8, CV_TOTAL = NLAYER * CV_LAYER + CV_ROPE + CV_C1 + 1;

struct TDesc { const float* src; const float* kscale; bf16_t* dst; int Nsrc, Ndst, n0, k0, kind; };
__device__ __forceinline__ TDesc conv_desc(const P& p, int it) {
  TDesc d; d.kscale = nullptr; d.kind = 0;
  int l = it / CV_LAYER, r = it % CV_LAYER;
  if (r < CV_WIN) {
    d.src = p.w_in + (long)l * DM * 2964; d.Nsrc = 2964; d.dst = p.WinT + (long)l * NP * DM; d.Ndst = NP; d.n0 = (r / 16) * 64; d.k0 = (r % 16) * 64; d.kind = 1; d.kscale = p.attn_norm_w + l * DM;
  } else if ((r -= CV_WIN) < CV_WOUT) {
    d.src = p.w_out + (long)l * DM * DM; d.Nsrc = DM; d.dst = p.WoutT + (long)l * DM * DM; d.Ndst = DM; d.n0 = (r / 16) * 64; d.k0 = (r % 16) * 64;
  } else if ((r -= CV_WOUT) < CV_WUP) {
    d.src = p.ffn_w_up + (long)l * DM * 2 * DFF; d.Nsrc = 2 * DFF; d.dst = p.WupT + (long)l * 5632 * DM; d.Ndst = 5632; d.n0 = (r / 16) * 64; d.k0 = (r % 16) * 64; d.kind = 2; d.kscale = p.ffn_norm_w + l * DM;
  } else if ((r -= CV_WUP) < CV_WDN) {
    d.src = p.ffn_w_down + (long)l * DFF * DM; d.Nsrc = DM; d.dst = p.WdownT + (long)l * DM * DFF; d.Ndst = DM; d.n0 = (r / 43) * 64; d.k0 = (r % 43) * 64;
  } else if ((r -= CV_WDN) < CV_W1) {
    d.src = p.cmp_k_w1 + (long)l * 2048 * 128; d.Nsrc = 128; d.dst = p.W1T + (long)(l * 2 + 0) * 128 * 2048; d.Ndst = 128; d.n0 = (r / 32) * 64; d.k0 = (r % 32) * 64;
  } else {
    r -= CV_W1;
    d.src = p.cmp_v_w1 + (long)l * 2048 * 128; d.Nsrc = 128; d.dst = p.W1T + (long)(l * 2 + 1) * 128 * 2048; d.Ndst = 128; d.n0 = (r / 32) * 64; d.k0 = (r % 32) * 64;
  }
  return d;
}
__device__ __forceinline__ void transpose_group4(const P& p, int it0, ldsp smem) {
  const int tid = tidx();
  const int n4 = (tid & 15) * 4, kr = tid >> 4;
  float4 v[4][4];
  TDesc d[4];
#pragma unroll
  for (int t = 0; t < 4; ++t) {
    d[t] = conv_desc(p, it0 + t);
    const int n = d[t].n0 + n4;
    const int sc = d[t].kind == 0 ? n : (d[t].kind == 1 ? map_win(n) : map_wup(n));
#pragma unroll
    for (int q = 0; q < 4; ++q) {
      const int k = d[t].k0 + kr + 16 * q;
      v[t][q] = sc >= 0 ? *(const float4*)(d[t].src + (long)k * d[t].Nsrc + sc) : make_float4(0.f, 0.f, 0.f, 0.f);
      if (d[t].kscale) { const float ks = d[t].kscale[k]; v[t][q].x *= ks; v[t][q].y *= ks; v[t][q].z *= ks; v[t][q].w *= ks; }
    }
  }
  __syncthreads();
#pragma unroll
  for (int t = 0; t < 4; ++t)
#pragma unroll
    for (int q = 0; q < 4; ++q) {
      const ldsp b = smem + t * 16640 + ((kr + 16 * q) * 65 + n4) * 4;
      stsf(b, v[t][q].x); stsf(b + 4, v[t][q].y); stsf(b + 8, v[t][q].z); stsf(b + 12, v[t][q].w);
    }
  __syncthreads();
#pragma unroll
  for (int t = 0; t < 4; ++t) {
    const int nn = tid >> 2, kc = (tid & 3) * 16;
    float w[16];
#pragma unroll
    for (int e = 0; e < 16; ++e) w[e] = ldsf(smem + t * 16640 + ((kc + e) * 65 + nn) * 4);
    u32x4 a, b;
    a.x = pk2(w[0], w[1]); a.y = pk2(w[2], w[3]); a.z = pk2(w[4], w[5]); a.w = pk2(w[6], w[7]);
    b.x = pk2(w[8], w[9]); b.y = pk2(w[10], w[11]); b.z = pk2(w[12], w[13]); b.w = pk2(w[14], w[15]);
    bf16_t* dp = d[t].dst + slab_idx(d[t].n0 + nn, d[t].k0 + kc, d[t].Ndst);
    *(u32x4*)dp = a;
    *(u32x4*)(dp + 8) = b;
  }
}
__device__ __forceinline__ void ph_convert(const P& p, ldsp smem) {
  const int tid = tidx();
  for (int gi = blockIdx.x; gi < NLAYER * CV_LAYER / 4; gi += gridDim.x) transpose_group4(p, gi * 4, smem);
  for (int it = NLAYER * CV_LAYER + blockIdx.x; it < CV_TOTAL; it += gridDim.x) {
    if (it < NLAYER * CV_LAYER) {
      int l = it / CV_LAYER, r = it % CV_LAYER;
      if (r < CV_WIN) {
        transpose_tile(p.w_in + (long)l * DM * 2964, 2964, p.WinT + (long)l * NP * DM, NP, (r / 16) * 64, (r % 16) * 64, 1, smem, p.attn_norm_w + l * DM);
      } else if ((r -= CV_WIN) < CV_WOUT) {
        transpose_tile(p.w_out + (long)l * DM * DM, DM, p.WoutT + (long)l * DM * DM, DM, (r / 16) * 64, (r % 16) * 64, 0, smem);
      } else if ((r -= CV_WOUT) < CV_WUP) {
        transpose_tile(p.ffn_w_up + (long)l * DM * 2 * DFF, 2 * DFF, p.WupT + (long)l * 5632 * DM, 5632, (r / 16) * 64, (r % 16) * 64, 2, smem, p.ffn_norm_w + l * DM);
      } else if ((r -= CV_WUP) < CV_WDN) {
        transpose_tile(p.ffn_w_down + (long)l * DFF * DM, DM, p.WdownT + (long)l * DM * DFF, DM, (r / 43) * 64, (r % 43) * 64, 0, smem);
      } else if ((r -= CV_WDN) < CV_W1) {
        transpose_tile(p.cmp_k_w1 + (long)l * 2048 * 128, 128, p.W1T + (long)(l * 2 + 0) * 128 * 2048, 128, (r / 32) * 64, (r % 32) * 64, 0, smem);
      } else {
        r -= CV_W1;
        transpose_tile(p.cmp_v_w1 + (long)l * 2048 * 128, 128, p.W1T + (long)(l * 2 + 1) * 128 * 2048, 128, (r / 32) * 64, (r % 32) * 64, 0, smem);
      }
    } else {
      int r = it - NLAYER * CV_LAYER;
      if (r < CV_ROPE) {
        int idx = r * 256 + tid;
        int t = idx >> 5, d = idx & 31;
        float inv = 1.0f / powf(10000.0f, (float)d / 32.0f);
        float ang = (float)t * inv;
        p.rope[t * 64 + d] = cosf(ang);
        p.rope[t * 64 + 32 + d] = sinf(ang);
      } else if ((r -= CV_ROPE) < CV_C1) {
        int l = r >> 1, kv = r & 1;
        const float* pos = (kv ? p.cmp_v_pos : p.cmp_k_pos) + (long)l * 2048;
        const float* w1 = (kv ? p.cmp_v_w1 : p.cmp_k_w1) + (long)l * 2048 * 128;
        const int n4 = (tid & 31) * 4, kg = tid >> 5;
        float4 ac = make_float4(0.f, 0.f, 0.f, 0.f);
#pragma unroll 8
        for (int k = kg * 256; k < kg * 256 + 256; ++k) {
          const float pk = pos[k];
          const float4 wv4 = *(const float4*)(w1 + (long)k * 128 + n4);
          ac.x += pk * wv4.x; ac.y += pk * wv4.y; ac.z += pk * wv4.z; ac.w += pk * wv4.w;
        }
        __syncthreads();
        stsf(smem + (kg * 128 + n4) * 4, ac.x); stsf(smem + (kg * 128 + n4 + 1) * 4, ac.y);
        stsf(smem + (kg * 128 + n4 + 2) * 4, ac.z); stsf(smem + (kg * 128 + n4 + 3) * 4, ac.w);
        __syncthreads();
        if (tid < 128) {
          float sacc = 0.f;
#pragma unroll
          for (int gq = 0; gq < 8; ++gq) sacc += ldsf(smem + (gq * 128 + tid) * 4);
          p.c1[(l * 2 + kv) * 128 + tid] = sacc;
        }
      } else {
        for (int e = tid; e < 2048; e += 256) p.zeros[e] = 0;
        for (int e2 = tid; e2 < NLAYER * 5 * 512; e2 += 256) {
          const int e = 2 * e2, l2 = e / 5120, r2 = (e % 5120) >> 10, c2 = e & 1023;
          const float* src = r2 < 4 ? p.ssd_conv_w + (long)l2 * 4096 + r2 * 1024 + c2 : p.ssd_conv_b + l2 * 1024 + c2;
          ((unsigned*)p.cwh)[e2] = pk2(src[0], src[1]);
        }
      }
    }
  }
}

__device__ __forceinline__ void ph_prepass(const P& p) {
  const int wave = tidx() >> 6, lane = tidx() & 63;
  for (int row = blockIdx.x * 4 + wave; row < NTOK; row += gridDim.x * 4) {
    const float4* xr = (const float4*)(p.x + (long)row * DM);
    float ss = 0.f;
#pragma unroll
    for (int k = 0; k < 4; ++k) {
      float4 v = xr[lane + 64 * k];
      ss += v.x * v.x + v.y * v.y + v.z * v.z + v.w * v.w;
      u32x2 o; o.x = pk2(v.x, v.y); o.y = pk2(v.z, v.w);
      *(u32x2*)(p.h + slab_idx(row, (lane + 64 * k) * 4, NTOK)) = o;
    }
#pragma unroll
    for (int o = 32; o >= 1; o >>= 1) ss += __shfl_xor(ss, o);
    if (lane < 8) p.ssqp[(long)row * 8 + lane] = lane == 0 ? ss : 0.f;
  }
}
__device__ __forceinline__ float row_rstd(const float* ssqp, long row) {
  float4 a = *(const float4*)(ssqp + row * 8), b = *(const float4*)(ssqp + row * 8 + 4);
  float ss = ((a.x + a.y) + (a.z + a.w)) + ((b.x + b.y) + (b.z + b.w));
  return rsqrtf(ss * (1.f / 1024.f) + 1e-6f);
}
__device__ __forceinline__ void ph_final(const P& p) {
  const int wave = tidx() >> 6, lane = tidx() & 63;
  for (int row = blockIdx.x * 4 + wave; row < NTOK; row += gridDim.x * 4) {
    float4 v[4];
    float ss = 0.f;
#pragma unroll
    for (int k = 0; k < 4; ++k) {
      u32x2 hv = *(const u32x2*)(p.h + slab_idx(row, (lane + 64 * k) * 4, NTOK));
      v[k].x = bflo(hv.x); v[k].y = bfhi(hv.x); v[k].z = bflo(hv.y); v[k].w = bfhi(hv.y);
      ss += v[k].x * v[k].x + v[k].y * v[k].y + v[k].z * v[k].z + v[k].w * v[k].w;
    }
#pragma unroll
    for (int o = 32; o >= 1; o >>= 1) ss += __shfl_xor(ss, o);
    const float rstd = rsqrtf(ss * (1.f / 1024.f) + 1e-6f);
#pragma unroll
    for (int k = 0; k < 4; ++k) {
      float4 w4 = ((const float4*)p.final_norm_w)[lane + 64 * k];
      float4 o; o.x = v[k].x * rstd * w4.x; o.y = v[k].y * rstd * w4.y; o.z = v[k].z * rstd * w4.z; o.w = v[k].w * rstd * w4.w;
      ((float4*)(p.out + (long)row * DM))[lane + 64 * k] = o;
    }
  }
}
__device__ __forceinline__ void ph_rmsnorm(const float* x, const float* w, bf16_t* h, float* outf) {
  const int wave = tidx() >> 6, lane = tidx() & 63;
  for (int row = blockIdx.x * 4 + wave; row < NTOK; row += gridDim.x * 4) {
    const float4* xr = (const float4*)(x + (long)row * DM);
    float4 v[4];
    float ss = 0.f;
#pragma unroll
    for (int k = 0; k < 4; ++k) {
      v[k] = xr[lane + 64 * k];
      ss += v[k].x * v[k].x + v[k].y * v[k].y + v[k].z * v[k].z + v[k].w * v[k].w;
    }
#pragma unroll
    for (int o = 32; o >= 1; o >>= 1) ss += __shfl_xor(ss, o);
    float rstd = rsqrtf(ss * (1.f / 1024.f) + 1e-6f);
#pragma unroll
    for (int k = 0; k < 4; ++k) {
      float4 w4 = ((const float4*)w)[lane + 64 * k];
      float a = v[k].x * rstd * w4.x, b = v[k].y * rstd * w4.y, c = v[k].z * rstd * w4.z, d = v[k].w * rstd * w4.w;
      if (h) {
        u32x2 o; o.x = pk2(a, b); o.y = pk2(c, d);
        *(u32x2*)(h + slab_idx(row, (lane + 64 * k) * 4, NTOK)) = o;
      } else {
        float4 o; o.x = a; o.y = b; o.z = c; o.w = d;
        ((float4*)(outf + (long)row * DM))[lane + 64 * k] = o;
      }
    }
  }
}

constexpr int GSTAGE = 24576;
__device__ __forceinline__ int gemm_chunk_off() {
  const int t = tidx();
  const int sq = (t >> 4) & 3;
  const int sv = (0x78 >> (2 * sq)) & 3;
  return ((t & 3) ^ sv) * 8;
}
__device__ __forceinline__ const char* uniform_ptr(const char* p) {
  unsigned long long v = (unsigned long long)p;
  unsigned lo = __builtin_amdgcn_readfirstlane((unsigned)v), hi = __builtin_amdgcn_readfirstlane((unsigned)(v >> 32));
  asm volatile("" : "+s"(lo), "+s"(hi));
  return (const char*)(((unsigned long long)hi << 32) | lo);
}
template <bool CMPA>
__device__ __forceinline__ void gemm_core(f32x4 (&acc)[8][4], const char* abase, const unsigned (&voffA)[2], size_t astep, const char* bbase,
                                          const unsigned (&voffB)[4], size_t bstep, int nk, ldsp smem) {
  const int tid = tidx(), lane = tid & 63, wid = tid >> 6, wr = wid >> 1, wc = wid & 1, i = lane & 15, g = lane >> 4;
#pragma unroll
  for (int nf = 0; nf < 8; ++nf)
#pragma unroll
    for (int mf = 0; mf < 4; ++mf) acc[nf][mf] = (f32x4){0.f, 0.f, 0.f, 0.f};
  asm volatile("s_waitcnt vmcnt(0)" ::: "memory");
  __syncthreads();
  const int wbase = __builtin_amdgcn_readfirstlane(tid >> 6) * 1024;
  auto stage = [&](int kt, int buf) {
    const char* ak = uniform_ptr(abase + (CMPA ? ((size_t)(kt >> 1) * NP + (kt & 1) * 32) * 2 : (size_t)kt * astep));
    const char* bk = uniform_ptr(bbase + (size_t)kt * bstep);
#pragma unroll
    for (int q = 0; q < 2; ++q)
      __builtin_amdgcn_global_load_lds((const unsigned*)(ak + voffA[q]), (LAS unsigned*)(smem + buf * GSTAGE + wbase + q * 4096), 16, 0, 0);
#pragma unroll
    for (int q = 0; q < 4; ++q)
      __builtin_amdgcn_global_load_lds((const unsigned*)(bk + voffB[q]), (LAS unsigned*)(smem + buf * GSTAGE + 8192 + wbase + q * 4096), 16, 0, 0);
  };
  stage(0, 0);
  if (nk > 1) stage(1, 1);
  const int sq = (i >> 2) & 3;
  const int sw = (g ^ ((0x78 >> (2 * sq)) & 3)) * 16;
  int buf = 0, nbuf = 2;
  for (int kt = 0; kt < nk; ++kt) {
    if (kt + 1 < nk) asm volatile("s_waitcnt vmcnt(6)" ::: "memory");
    else asm volatile("s_waitcnt vmcnt(0)" ::: "memory");
    __builtin_amdgcn_s_barrier();
    asm volatile("" ::: "memory");
    ldsp sa = smem + buf * GSTAGE, sb = sa + 8192;
    bf16x8 a[4], b0[4];
#pragma unroll
    for (int mf = 0; mf < 4; ++mf) a[mf] = ld128(sa + (wr * 64 + mf * 16 + i) * 64 + sw);
#pragma unroll
    for (int nf = 0; nf < 4; ++nf) b0[nf] = ld128(sb + (wc * 128 + nf * 16 + i) * 64 + sw);
    if (kt + 2 < nk) stage(kt + 2, nbuf);
    bf16x8 b[4];
#pragma unroll
    for (int nf = 0; nf < 2; ++nf) b[nf] = ld128(sb + (wc * 128 + (4 + nf) * 16 + i) * 64 + sw);
    __builtin_amdgcn_s_setprio(1);
#pragma unroll
    for (int nf = 0; nf < 4; ++nf)
#pragma unroll
      for (int mf = 0; mf < 4; ++mf) acc[nf][mf] = mfma16(b0[nf], a[mf], acc[nf][mf]);
    __builtin_amdgcn_s_setprio(0);
    {
#pragma unroll
      for (int nf = 2; nf < 4; ++nf) b[nf] = ld128(sb + (wc * 128 + (4 + nf) * 16 + i) * 64 + sw);
      __builtin_amdgcn_s_setprio(1);
#pragma unroll
      for (int nf = 0; nf < 4; ++nf)
#pragma unroll
        for (int mf = 0; mf < 4; ++mf) acc[4 + nf][mf] = mfma16(b[nf], a[mf], acc[4 + nf][mf]);
      __builtin_amdgcn_s_setprio(0);
    }
    buf = buf == 2 ? 0 : buf + 1;
    nbuf = nbuf == 2 ? 0 : nbuf + 1;
  }
  __syncthreads();
}
__device__ __forceinline__ void tile_map(int t, int NT, int& mt, int& nt) {
  int xcd = t & 7, local = t >> 3;
  nt = local % NT;
  mt = (local / NT) * 8 + xcd;
}

__device__ __forceinline__ void ph_inproj(const P& p, int layer, ldsp smem) {
  const int tid = tidx(), lane = tid & 63, wid = tid >> 6, wr = wid >> 1, wc = wid & 1, i = lane & 15, g = lane >> 4;
  const bf16_t* Bt = p.WinT + (long)layer * NP * DM;
  const int co = gemm_chunk_off();
  for (int tile = blockIdx.x; tile < 256 * 12; tile += gridDim.x) {
    int mt, nt;
    tile_map(tile, 12, mt, nt);
    int m0 = mt * 128, n0 = nt * 256;
    unsigned voffA[2], voffB[4];
#pragma unroll
    for (int q = 0; q < 2; ++q) voffA[q] = (unsigned)(((tid >> 2) + 64 * q) * 32 + co) * 2u;
#pragma unroll
    for (int q = 0; q < 4; ++q) voffB[q] = (unsigned)(((tid >> 2) + 64 * q) * 32 + co) * 2u;
    f32x4 acc[8][4];
    gemm_core<false>(acc, (const char*)(p.h + (long)m0 * 32), voffA, (size_t)NTOK * 64, (const char*)(Bt + (long)n0 * 32), voffB, (size_t)NP * 64, DM / 32, smem);
#pragma unroll
    for (int mf = 0; mf < 4; ++mf) {
      const float rs = row_rstd(p.ssqp, m0 + wr * 64 + mf * 16 + i);
#pragma unroll
      for (int nf = 0; nf < 8; ++nf) acc[nf][mf] *= rs;
    }
#pragma unroll
    for (int hh = 0; hh < 2; ++hh) {
      int unit = (n0 + wc * 128 + hh * 64) >> 6;
      bool dorope = (unit >= 36 && unit <= 40) || unit == 42 || unit == 44;
      float qs = (unit >= 36 && unit <= 39) ? 0.125f * 1.4426950408889634f : 1.0f;
#pragma unroll
      for (int mf = 0; mf < 4; ++mf) {
        int row = m0 + wr * 64 + mf * 16 + i;
        if (dorope) {
          int t = row & (SEQ - 1);
#pragma unroll
          for (int n = 0; n < 2; ++n) {
            float4 c4 = *(const float4*)(p.rope + t * 64 + n * 16 + 4 * g);
            float4 s4 = *(const float4*)(p.rope + t * 64 + 32 + n * 16 + 4 * g);
            const float cc[4] = {c4.x, c4.y, c4.z, c4.w}, ss[4] = {s4.x, s4.y, s4.z, s4.w};
#pragma unroll
            for (int r = 0; r < 4; ++r) {
              float x1 = acc[hh * 4 + n][mf][r], x2 = acc[hh * 4 + n + 2][mf][r];
              acc[hh * 4 + n][mf][r] = (x1 * cc[r] - x2 * ss[r]) * qs;
              acc[hh * 4 + n + 2][mf][r] = (x2 * cc[r] + x1 * ss[r]) * qs;
            }
          }
        }
#pragma unroll
        for (int n = 0; n < 4; ++n) {
          f32x4 v = acc[hh * 4 + n][mf];
          u32x2 o; o.x = pk2(v[0], v[1]); o.y = pk2(v[2], v[3]);
          *(u32x2*)(p.proj + (long)row * NP + n0 + wc * 128 + (hh * 4 + n) * 16 + 4 * g) = o;
        }
      }
    }
  }
}

__device__ __forceinline__ void ph_resgemm(const bf16_t* A, int K, const bf16_t* Bt, bf16_t* hout, float* ssqp, ldsp smem) {
  const int tid = tidx(), lane = tid & 63, wid = tid >> 6, wr = wid >> 1, wc = wid & 1, i = lane & 15, g = lane >> 4;
  const int co = gemm_chunk_off();
  for (int tile = blockIdx.x; tile < 256 * 4; tile += gridDim.x) {
    int mt, nt;
    tile_map(tile, 4, mt, nt);
    int m0 = mt * 128, n0 = nt * 256;
    unsigned voffA[2], voffB[4];
#pragma unroll
    for (int q = 0; q < 2; ++q) voffA[q] = (unsigned)(((tid >> 2) + 64 * q) * 32 + co) * 2u;
#pragma unroll
    for (int q = 0; q < 4; ++q) voffB[q] = (unsigned)(((tid >> 2) + 64 * q) * 32 + co) * 2u;
    f32x4 acc[8][4];
    gemm_core<false>(acc, (const char*)(A + (long)m0 * 32), voffA, (size_t)NTOK * 64, (const char*)(Bt + (long)n0 * 32), voffB, (size_t)DM * 64, K / 32, smem);
#pragma unroll
    for (int mf = 0; mf < 4; ++mf) {
      long row = m0 + wr * 64 + mf * 16 + i;
      u32x2 xi[8];
#pragma unroll
      for (int nf = 0; nf < 8; ++nf) xi[nf] = *(const u32x2*)(hout + slab_idx(row, n0 + wc * 128 + nf * 16 + 4 * g, NTOK));
      float ss = 0.f;
#pragma unroll
      for (int nf = 0; nf < 8; ++nf) {
        f32x4 v = acc[nf][mf];
        float4 o; o.x = bflo(xi[nf].x) + v[0]; o.y = bfhi(xi[nf].x) + v[1]; o.z = bflo(xi[nf].y) + v[2]; o.w = bfhi(xi[nf].y) + v[3];
        ss += o.x * o.x + o.y * o.y + o.z * o.z + o.w * o.w;
        u32x2 hb; hb.x = pk2(o.x, o.y); hb.y = pk2(o.z, o.w);
        *(u32x2*)(hout + slab_idx(row, n0 + wc * 128 + nf * 16 + 4 * g, NTOK)) = hb;
      }
      ss += __shfl_xor(ss, 16);
      ss += __shfl_xor(ss, 32);
      if (g == 0) ssqp[row * 8 + nt * 2 + wc] = ss;
      asm volatile("" ::: "memory");
    }
  }
}

__device__ __forceinline__ void cmp_gemm1_tile(const P& p, int layer, int item, ldsp smem) {
  asm volatile("" : "+s"(layer));
  const int tid = tidx(), lane = tid & 63, wid = tid >> 6, wr = wid >> 1, wc = wid & 1, i = lane & 15, g = lane >> 4;
  const int co = gemm_chunk_off();
  int kv = item >> 4, mt = item & 15;
  int m0 = mt * 128;
  const bf16_t* A = p.proj + (kv ? C_VC : C_KC);
  const bf16_t* Bt = p.W1T + (long)(layer * 2 + kv) * 128 * 2048;
  unsigned voffA[2], voffB[4];
#pragma unroll
  for (int q = 0; q < 2; ++q) voffA[q] = (unsigned)(((tid >> 2) + 64 * q) * 16 * NP + co) * 2u;
#pragma unroll
  for (int q = 0; q < 4; ++q) voffB[q] = (unsigned)(((tid >> 2) + 64 * (q & 1)) * 32 + co) * 2u;
  f32x4 acc[8][4];
  gemm_core<true>(acc, (const char*)(A + (long)m0 * 16 * NP), voffA, 0, (const char*)Bt, voffB, (size_t)128 * 64, 64, smem);
  const float* c1 = p.c1 + (layer * 2 + kv) * 128;
  bf16_t* hid = p.hid + (long)kv * 2048 * 128;
  if (wc == 0) {
#pragma unroll
    for (int mf = 0; mf < 4; ++mf) {
      int row = m0 + wr * 64 + mf * 16 + i;
#pragma unroll
      for (int nf = 0; nf < 8; ++nf) {
        int col = nf * 16 + 4 * g;
        float4 cb = *(const float4*)(c1 + col);
        f32x4 v = acc[nf][mf];
        u32x2 o;
        o.x = pk2(geluf(v[0] + cb.x), geluf(v[1] + cb.y));
        o.y = pk2(geluf(v[2] + cb.z), geluf(v[3] + cb.w));
        *(u32x2*)(hid + (long)row * 128 + col) = o;
      }
    }
  }
}

__device__ __forceinline__ void ph_ffn_up(const P& p, int layer, ldsp smem) {
  const int tid = tidx(), lane = tid & 63, wid = tid >> 6, wr = wid >> 1, wc = wid & 1, i = lane & 15, g = lane >> 4;
  const int co = gemm_chunk_off();
  const bf16_t* Bt = p.WupT + (long)layer * 5632 * DM;
  const float* cw = p.ffn_conv_w + (long)layer * 3 * 2 * DFF;
  const float* cb = p.ffn_conv_b + (long)layer * 2 * DFF;
  constexpr int MT = 264, NT = 22;
  for (int tile = blockIdx.x; tile < MT * NT; tile += gridDim.x) {
    int mtb, nt;
    tile_map(tile, NT, mtb, nt);
    int b = mtb / 66, mj = mtb % 66;
    int tokbase = 126 * mj - 2;
    unsigned voffA[2], voffB[4];
#pragma unroll
    for (int q = 0; q < 2; ++q) {
      int tk = tokbase + (tid >> 2) + 64 * q;
      tk = tk < 0 ? 0 : (tk >= SEQ ? SEQ - 1 : tk);
      voffA[q] = (unsigned)(tk * 32 + co) * 2u;
    }
#pragma unroll
    for (int q = 0; q < 4; ++q) voffB[q] = (unsigned)(((tid >> 2) + 64 * q) * 32 + co) * 2u;
    f32x4 acc[8][4];
    gemm_core<false>(acc, (const char*)(p.h + (long)b * SEQ * 32), voffA, (size_t)NTOK * 64, (const char*)(Bt + (long)nt * 256 * 32), voffB, (size_t)5632 * 64, DM / 32, smem);
#pragma unroll
    for (int mf = 0; mf < 4; ++mf) {
      const int tkr = tokbase + wr * 64 + mf * 16 + i;
      const float rs = (tkr >= 0 && tkr < SEQ) ? row_rstd(p.ssqp, (long)b * SEQ + tkr) : 0.f;
#pragma unroll
      for (int nf = 0; nf < 8; ++nf) {
        int r = wr * 64 + mf * 16 + i, c = wc * 128 + nf * 16 + 4 * g;
        f32x4 v = acc[nf][mf] * rs;
        u32x2 o; o.x = pk2(v[0], v[1]); o.y = pk2(v[2], v[3]);
        *(LAS u32x2*)(smem + r * 528 + c * 2) = o;
      }
    }
    __syncthreads();
    {
      const int ac = (tid & 15) * 8;
      const int pi = ac >> 6, pc = ac & 63;
      const int pair = 2 * nt + pi;
      if (pair < 43) {
        const int gcol = pair * 64 + pc;
        const int lg = (pi * 128 + pc) * 2, lv = (pi * 128 + 64 + pc) * 2;
        h16x2 wg[3][4], wv[3][4], bg[4], bv[4];
#pragma unroll
        for (int q = 0; q < 4; ++q) {
#pragma unroll
          for (int j = 0; j < 3; ++j) {
            const float2 a2 = *(const float2*)(cw + j * 2 * DFF + gcol + 2 * q), b2 = *(const float2*)(cw + j * 2 * DFF + DFF + gcol + 2 * q);
            wg[j][q].x = (_Float16)a2.x; wg[j][q].y = (_Float16)a2.y;
            wv[j][q].x = (_Float16)b2.x; wv[j][q].y = (_Float16)b2.y;
          }
          const float2 c2 = *(const float2*)(cb + gcol + 2 * q), d2 = *(const float2*)(cb + DFF + gcol + 2 * q);
          bg[q].x = (_Float16)c2.x; bg[q].y = (_Float16)c2.y;
          bv[q].x = (_Float16)d2.x; bv[q].y = (_Float16)d2.y;
        }
#pragma unroll 2
        for (int it = 0; it < 8; ++it) {
          int r = 2 + (tid >> 4) + 16 * it;
          int tk = tokbase + r;
          if (r < 128 && tk < SEQ) {
            h16x2 ga[4], va[4];
#pragma unroll
            for (int q = 0; q < 4; ++q) { ga[q] = bg[q]; va[q] = bv[q]; }
#pragma unroll
            for (int j = 0; j < 3; ++j) {
              const u32x4 tg = *(LAS const u32x4*)(smem + (r - 2 + j) * 528 + lg);
              const u32x4 tv = *(LAS const u32x4*)(smem + (r - 2 + j) * 528 + lv);
              const unsigned tgs[4] = {tg.x, tg.y, tg.z, tg.w}, tvs[4] = {tv.x, tv.y, tv.z, tv.w};
#pragma unroll
              for (int q = 0; q < 4; ++q) {
                ga[q] = wg[j][q] * __builtin_bit_cast(h16x2, tgs[q]) + ga[q];
                va[q] = wv[j][q] * __builtin_bit_cast(h16x2, tvs[q]) + va[q];
              }
            }
            u32x4 ov;
            unsigned ow[4];
#pragma unroll
            for (int q = 0; q < 4; ++q) ow[q] = pk2(siluf((float)ga[q].x) * (float)va[q].x, siluf((float)ga[q].y) * (float)va[q].y);
            ov.x = ow[0]; ov.y = ow[1]; ov.z = ow[2]; ov.w = ow[3];
            *(u32x4*)(p.act + slab_idx((long)b * SEQ + tk, gcol, NTOK)) = ov;
          }
        }
      }
    }
  }
}

__device__ __forceinline__ void xbc_conv8(const P& p, int layer, long row, int tb, int ccol, float* o) {
  const bf16_t* wh = p.cwh + (long)layer * 5120 + ccol;
  const u32x4 bb = gld128(wh + 4096);
  h16x2 acc0 = as_h2(bb.x), acc1 = as_h2(bb.y), acc2 = as_h2(bb.z), acc3 = as_h2(bb.w);
#pragma unroll
  for (int j = 0; j < 4; ++j) {
    if (tb - 3 + j >= 0) {
      const u32x4 v = gld128(p.proj + (row - 3 + j) * NP + C_XBC + ccol);
      const u32x4 w = gld128(wh + j * 1024);
      acc0 = as_h2(w.x) * as_h2(v.x) + acc0;
      acc1 = as_h2(w.y) * as_h2(v.y) + acc1;
      acc2 = as_h2(w.z) * as_h2(v.z) + acc2;
      acc3 = as_h2(w.w) * as_h2(v.w) + acc3;
    }
  }
  o[0] = siluf((float)acc0.x); o[1] = siluf((float)acc0.y); o[2] = siluf((float)acc1.x); o[3] = siluf((float)acc1.y);
  o[4] = siluf((float)acc2.x); o[5] = siluf((float)acc2.y); o[6] = siluf((float)acc3.x); o[7] = siluf((float)acc3.y);
}

__device__ __forceinline__ void ssd_dt_scan(const P& p, int layer, long row0, int hd, int lane, ldsp dts, ldsp acs) {
  float dtr = bf2f(p.proj[(row0 + lane) * NP + C_DT + hd]) + p.ssd_dt_bias[layer * 8 + hd];
  float dt = softplusf(dtr);
  float a = -dt * expf(p.ssd_a_log[layer * 8 + hd]);
  float cs = a;
#pragma unroll
  for (int o = 1; o < 64; o <<= 1) {
    float t = __shfl_up(cs, o);
    if (lane >= o) cs += t;
  }
  stsf(dts + lane * 4, dt);
  stsf(acs + lane * 4, cs);
}

__device__ __forceinline__ void ssd1_item(const P& p, int layer, int item, ldsp smem) {
  asm volatile("" : "+s"(layer));
  const int tid = tidx(), lane = tid & 63, w = tid >> 6, i = lane & 15, g = lane >> 4;
  int b = item >> 8, c = (item >> 1) & 127, grp = item & 1;
  long row0 = (long)b * SEQ + c * 64;
  int tb0 = c * 64;
  ldsp Bs = smem, Xs = smem + 17408, dts = smem + 51200, acs = smem + 52224;
  __syncthreads();
  ssd_dt_scan(p, layer, row0, 4 * grp + w, lane, dts + w * 256, acs + w * 256);
  __syncthreads();
#pragma unroll 1
  for (int it = 0; it < 4; ++it) {
    int r = (tid >> 4) + 16 * it, ch = tid & 15;
    float o[8];
    xbc_conv8(p, layer, row0 + r, tb0 + r, 512 + 128 * grp + ch * 8, o);
    st128(Bs + r * 272 + ch * 16, __builtin_bit_cast(u32x4, pack8(o)));
  }
#pragma unroll 2
  for (int it = 0; it < 8; ++it) {
    int r = (tid >> 5) + 8 * it, ch = tid & 31;
    int hh = ch >> 3;
    float o[8];
    xbc_conv8(p, layer, row0 + r, tb0 + r, (4 * grp) * 64 + ch * 8, o);
    float sc = ldsf(dts + hh * 256 + r * 4) * __expf(ldsf(acs + hh * 256 + 63 * 4) - ldsf(acs + hh * 256 + r * 4));
#pragma unroll
    for (int e = 0; e < 8; ++e) o[e] *= sc;
    st128(Xs + r * 528 + ch * 16, __builtin_bit_cast(u32x4, pack8(o)));
  }
  __syncthreads();
  int hd = 4 * grp + w;
  bf16_t* st = p.states + (((long)b * 128 + c) * 8 + hd) * 8192;
#pragma unroll 1
  for (int nh = 0; nh < 2; ++nh) {
    f32x4 acc[4][4];
#pragma unroll
    for (int pf = 0; pf < 4; ++pf)
#pragma unroll
      for (int nf = 0; nf < 4; ++nf) acc[pf][nf] = (f32x4){0.f, 0.f, 0.f, 0.f};
#pragma unroll
    for (int ks = 0; ks < 2; ++ks) {
      bf16x8 af[4], bfr[4];
      int rr = 32 * ks + 8 * g + (i >> 2);
#pragma unroll
      for (int pf = 0; pf < 4; ++pf) {
        ldsp a = Xs + rr * 528 + (64 * w + 16 * pf + 4 * (i & 3)) * 2;
        af[pf] = cat4(ldtr(a), ldtr(a + 4 * 528));
      }
#pragma unroll
      for (int nf = 0; nf < 4; ++nf) {
        ldsp a = Bs + rr * 272 + (16 * (4 * nh + nf) + 4 * (i & 3)) * 2;
        bfr[nf] = cat4(ldtr(a), ldtr(a + 4 * 272));
      }
#pragma unroll
      for (int pf = 0; pf < 4; ++pf)
#pragma unroll
        for (int nf = 0; nf < 4; ++nf) acc[pf][nf] = mfma16(bfr[nf], af[pf], acc[pf][nf]);
    }
#pragma unroll
    for (int pf = 0; pf < 4; ++pf)
#pragma unroll
      for (int nf = 0; nf < 4; ++nf)
      {
        const f32x4 v = acc[pf][nf];
        u32x2 o; o.x = pk2(v[0], v[1]); o.y = pk2(v[2], v[3]);
        *(u32x2*)(st + (16 * pf + i) * 128 + 16 * (4 * nh + nf) + 4 * g) = o;
      }
  }
  if (lane == 0) p.cdec[((long)b * 128 + c) * 8 + hd] = __expf(ldsf(acs + w * 256 + 63 * 4));
}

__device__ __forceinline__ void ssd2_item(const P& p, int item) {
  asm volatile("" : "+s"(item));
  int idx = item * 256 + tidx();
  int bh = idx >> 12, e = idx & 4095;
  int b = bh >> 3, hd = bh & 7;
  unsigned* S = (unsigned*)p.states;
  float h0 = 0.f, h1 = 0.f;
  for (int c0 = 0; c0 < 128; c0 += 16) {
    unsigned v[16]; float dc[16];
#pragma unroll
    for (int u = 0; u < 16; ++u) {
      long cb = ((long)b * 128 + c0 + u) * 8 + hd;
      v[u] = S[cb * 4096 + e];
      dc[u] = p.cdec[cb];
    }
#pragma unroll
    for (int u = 0; u < 16; ++u) {
      long cb = ((long)b * 128 + c0 + u) * 8 + hd;
      S[cb * 4096 + e] = pk2(h0, h1);
      h0 = h0 * dc[u] + bflo(v[u]);
      h1 = h1 * dc[u] + bfhi(v[u]);
    }
  }
}

__device__ __forceinline__ void cmp_gemm2_item(const P& p, int layer, int item) {
  asm volatile("" : "+s"(layer));
  int idx = item * 256 + tidx();
  int kv = idx >> 17, m = (idx >> 6) & 2047, d = idx & 63;
  const float* w2 = (kv ? p.cmp_v_w2 : p.cmp_k_w2) + (long)layer * 128 * 64;
  const bf16_t* hr = p.hid + ((long)kv * 2048 + m) * 128;
  float s = 0.f;
  if ((m & 511) != 511) {
    for (int n8 = 0; n8 < 16; ++n8) {
      float v[8];
      unpack8(gld128(hr + n8 * 8), v);
#pragma unroll
      for (int e = 0; e < 8; ++e) s += v[e] * w2[(n8 * 8 + e) * 64 + d];
    }
  }
  p.kcvc[((long)kv * 2048 + m) * 64 + d] = f2bf(s);
}

__device__ __forceinline__ void shortconv_item(const P& p, int layer, int item) {
  asm volatile("" : "+s"(layer));
  const int tid = tidx();
  const float* cw = p.sc_conv_w + (long)layer * 3 * 256;
  for (int it = 0; it < 8; ++it) {
    int q = it * 256 + tid;
    int r = q >> 5, ch = q & 31;
    long row = (long)item * 64 + r;
    int tb = (int)(row & (SEQ - 1));
    float o[8];
#pragma unroll
    for (int e = 0; e < 8; ++e) o[e] = 0.f;
#pragma unroll
    for (int j = 0; j < 3; ++j) {
      if (tb - 2 + j >= 0) {
        float a[8], bb[8];
        unpack8(gld128(p.proj + (row - 2 + j) * NP + C_SCC + ch * 8), a);
        unpack8(gld128(p.proj + (row - 2 + j) * NP + C_SCH + ch * 8), bb);
#pragma unroll
        for (int e = 0; e < 8; ++e) o[e] += cw[j * 256 + ch * 8 + e] * (a[e] * bb[e]);
      }
    }
    float sb[8];
    unpack8(gld128(p.proj + row * NP + C_SCB + ch * 8), sb);
#pragma unroll
    for (int e = 0; e < 8; ++e) o[e] *= sb[e];
    *(u32x4*)(p.ymix + slab_idx(row, 512 + ch * 8, NTOK)) = __builtin_bit_cast(u32x4, pack8(o));
  }
}

__device__ __forceinline__ void ssd3_item(const P& p, int layer, int item, ldsp smem) {
  asm volatile("" : "+s"(layer));
  const int tid = tidx(), lane = tid & 63, w = tid >> 6, i = lane & 15, g = lane >> 4;
  int b = item >> 7, c = item & 127;
  long row0 = (long)b * SEQ + c * 64;
  int tb0 = c * 64;
  ldsp Cs = smem, Bs = smem + 17408, Xh = smem + 34816, dts = smem + 44032, acs = smem + 45056;
  float ssq = 0.f;
  const int lq = 16 * w + i;
#pragma unroll 1
  for (int grp = 0; grp < 2; ++grp) {
    __syncthreads();
    ssd_dt_scan(p, layer, row0, 4 * grp + w, lane, dts + w * 256, acs + w * 256);
    for (int it = 0; it < 4; ++it) {
      int r = (tid >> 4) + 16 * it, ch = tid & 15;
      float o[8];
      xbc_conv8(p, layer, row0 + r, tb0 + r, 768 + 128 * grp + ch * 8, o);
      st128(Cs + r * 272 + ch * 16, __builtin_bit_cast(u32x4, pack8(o)));
      xbc_conv8(p, layer, row0 + r, tb0 + r, 512 + 128 * grp + ch * 8, o);
      st128(Bs + r * 272 + ch * 16, __builtin_bit_cast(u32x4, pack8(o)));
    }
    __syncthreads();
    bf16x8 cf[4];
#pragma unroll
    for (int ks = 0; ks < 4; ++ks) cf[ks] = ld128(Cs + lq * 272 + (32 * ks + 8 * g) * 2);
    f32x4 sT[4];
#pragma unroll
    for (int sf = 0; sf < 4; ++sf) {
      sT[sf] = (f32x4){0.f, 0.f, 0.f, 0.f};
#pragma unroll
      for (int ks = 0; ks < 4; ++ks) sT[sf] = mfma16(ld128(Bs + (16 * sf + i) * 272 + (32 * ks + 8 * g) * 2), cf[ks], sT[sf]);
    }
#pragma unroll 1
    for (int hh = 0; hh < 4; ++hh) {
      const int hd = 4 * grp + hh;
      __syncthreads();
      {
        const bf16_t* st = p.states + (((long)b * 128 + c) * 8 + hd) * 8192;
        for (int it = 0; it < 4; ++it) {
          int r = (tid >> 4) + 16 * it, ch = tid & 15;
          st128(Bs + r * 272 + ch * 16, gld128(st + r * 128 + ch * 8));
        }
        for (int it = 0; it < 2; ++it) {
          int r = (tid >> 3) + 32 * it, ch = tid & 7;
          float o[8];
          xbc_conv8(p, layer, row0 + r, tb0 + r, hd * 64 + ch * 8, o);
          st128(Xh + r * 144 + ch * 16, __builtin_bit_cast(u32x4, pack8(o)));
        }
      }
      __syncthreads();
      f32x4 acc[4];
#pragma unroll
      for (int pf = 0; pf < 4; ++pf) {
        acc[pf] = (f32x4){0.f, 0.f, 0.f, 0.f};
#pragma unroll
        for (int ks = 0; ks < 4; ++ks) acc[pf] = mfma16(ld128(Bs + (16 * pf + i) * 272 + (32 * ks + 8 * g) * 2), cf[ks], acc[pf]);
      }
      const float al = ldsf(acs + hh * 256 + lq * 4);
      const float el = __expf(al);
#pragma unroll
      for (int pf = 0; pf < 4; ++pf) acc[pf] *= el;
      const float Dh = p.ssd_d[layer * 8 + hd];
      f32x4 pt[4];
#pragma unroll
      for (int sf = 0; sf < 4; ++sf)
#pragma unroll
        for (int r = 0; r < 4; ++r) {
          int s = 16 * sf + 4 * g + r;
          float v = 0.f;
          if (s <= lq) v = sT[sf][r] * ldsf(dts + hh * 256 + s * 4) * __expf(al - ldsf(acs + hh * 256 + s * 4));
          if (s == lq) v += Dh;
          pt[sf][r] = v;
        }
#pragma unroll
      for (int ks = 0; ks < 2; ++ks) {
        bf16x8 pb = pack44(pt[2 * ks], pt[2 * ks + 1]);
#pragma unroll
        for (int pf = 0; pf < 4; ++pf) {
          ldsp a = Xh + (32 * ks + 4 * g + (i >> 2)) * 144 + (16 * pf + 4 * (i & 3)) * 2;
          acc[pf] = mfma16(cat4(ldtr(a), ldtr(a + 16 * 144)), pb, acc[pf]);
        }
      }
#pragma unroll
      for (int pf = 0; pf < 4; ++pf) {
        int col = hd * 64 + 16 * pf + 4 * g;
        u32x2 zz = *(const u32x2*)(p.proj + (row0 + lq) * NP + C_Z + col);
        float z0 = bflo(zz.x), z1 = bfhi(zz.x), z2 = bflo(zz.y), z3 = bfhi(zz.y);
        f32x4 y;
        y[0] = acc[pf][0] * siluf(z0); y[1] = acc[pf][1] * siluf(z1);
        y[2] = acc[pf][2] * siluf(z2); y[3] = acc[pf][3] * siluf(z3);
        ssq += y[0] * y[0] + y[1] * y[1] + y[2] * y[2] + y[3] * y[3];
        { u32x2 yp; yp.x = pk2(y[0], y[1]); yp.y = pk2(y[2], y[3]); *(u32x2*)(p.ymix + slab_idx(row0 + lq, col, NTOK)) = yp; }
      }
    }
  }
  ssq += __shfl_xor(ssq, 16);
  ssq += __shfl_xor(ssq, 32);
  const float rstd = rsqrtf(ssq * (1.f / 512.f) + 1e-6f);
  const float* nw = p.ssd_norm_w + layer * 512;
#pragma unroll 1
  for (int q = 0; q < 32; ++q) {
    int col = (q >> 2) * 64 + 16 * (q & 3) + 4 * g;
    float4 w4 = *(const float4*)(nw + col);
    u32x2* yp_ = (u32x2*)(p.ymix + slab_idx(row0 + lq, col, NTOK));
    u32x2 yp = *yp_;
    u32x2 o;
    o.x = pk2(bflo(yp.x) * rstd * w4.x, bfhi(yp.x) * rstd * w4.y);
    o.y = pk2(bflo(yp.y) * rstd * w4.z, bfhi(yp.y) * rstd * w4.w);
    *yp_ = o;
  }
}

template <int NH>
__device__ __forceinline__ void qk_tile(f32x4 (&s)[4][NH], ldsp Ks, const bf16x8 (&qf)[NH][2], int i, int g) {
#pragma unroll
  for (int kf = 0; kf < 4; ++kf)
#pragma unroll
    for (int h = 0; h < NH; ++h) s[kf][h] = (f32x4){0.f, 0.f, 0.f, 0.f};
  __builtin_amdgcn_s_setprio(1);
#pragma unroll
  for (int ks = 0; ks < 2; ++ks)
#pragma unroll
    for (int kf = 0; kf < 4; ++kf) {
      bf16x8 a = ld128(Ks + (16 * kf + i) * 144 + (32 * ks + 8 * g) * 2);
#pragma unroll
      for (int h = 0; h < NH; ++h) s[kf][h] = mfma16(a, qf[h][ks], s[kf][h]);
    }
  __builtin_amdgcn_s_setprio(0);
}
__device__ __forceinline__ void pv_tile(f32x4 (&o)[4][2], ldsp Vs, const f32x4 (&s)[4][2], int i, int g) {
  __builtin_amdgcn_s_setprio(1);
#pragma unroll
  for (int ks = 0; ks < 2; ++ks) {
    bf16x8 pb[2];
#pragma unroll
    for (int h = 0; h < 2; ++h) pb[h] = pack44_rtz(s[2 * ks][h], s[2 * ks + 1][h]);
#pragma unroll
    for (int df = 0; df < 4; ++df) {
      ldsp a = Vs + (32 * ks + 4 * g + (i >> 2)) * 144 + (16 * df + 4 * (i & 3)) * 2;
      bf16x8 av = cat4(ldtr(a), ldtr(a + 16 * 144));
#pragma unroll
      for (int h = 0; h < 2; ++h) o[df][h] = mfma16(av, pb[h], o[df][h]);
    }
  }
  __builtin_amdgcn_s_setprio(0);
}
__device__ __forceinline__ void stage64_ld(u32x4 (&r)[2], const bf16_t* src, long stride) {
  const int tid = tidx();
#pragma unroll
  for (int it = 0; it < 2; ++it) r[it] = gld128(src + (long)((tid >> 3) + 32 * it) * stride + (tid & 7) * 8);
}
__device__ __forceinline__ void stage64_st(const u32x4 (&r)[2], ldsp dst) {
  const int tid = tidx();
#pragma unroll
  for (int it = 0; it < 2; ++it) st128(dst + ((tid >> 3) + 32 * it) * 144 + (tid & 7) * 16, r[it]);
}

__device__ __forceinline__ void osm_update(f32x4 (&s)[4][2], const bool (&vm)[4][4], float (&m)[2], float (&l)[2], f32x4 (&o)[4][2]) {
#pragma unroll
  for (int h = 0; h < 2; ++h) {
    float tmax = -1e30f;
#pragma unroll
    for (int kf = 0; kf < 4; ++kf)
#pragma unroll
      for (int r = 0; r < 4; ++r) {
        float v = vm[kf][r] ? s[kf][h][r] : -1e30f;
        tmax = fmaxf(tmax, v);
      }
    tmax = fmaxf(tmax, __shfl_xor(tmax, 16));
    tmax = fmaxf(tmax, __shfl_xor(tmax, 32));
    float mnew = fmaxf(m[h], tmax);
    float alpha = ex2(m[h] - mnew);
    m[h] = mnew;
    float ps = 0.f;
#pragma unroll
    for (int kf = 0; kf < 4; ++kf)
#pragma unroll
      for (int r = 0; r < 4; ++r) {
        float pv = vm[kf][r] ? ex2(s[kf][h][r] - mnew) : 0.f;
        s[kf][h][r] = pv;
        ps += pv;
      }
    l[h] = l[h] * alpha + ps;
#pragma unroll
    for (int df = 0; df < 4; ++df) o[df][h] *= alpha;
  }
}

template <bool LANEMASK>
__device__ __forceinline__ void osm_update_full(f32x4 (&s)[4][2], bool lv, float (&m)[2], float (&l)[2], f32x4 (&o)[4][2]) {
#pragma unroll
  for (int h = 0; h < 2; ++h) {
    float tmax = s[0][h][0];
#pragma unroll
    for (int kf = 0; kf < 4; ++kf)
#pragma unroll
      for (int r = 0; r < 4; ++r) tmax = fmaxf(tmax, s[kf][h][r]);
    if (LANEMASK) tmax = lv ? tmax : -1e30f;
    tmax = fmaxf(tmax, __shfl_xor(tmax, 16));
    tmax = fmaxf(tmax, __shfl_xor(tmax, 32));
    float mnew = fmaxf(m[h], tmax);
    float alpha = ex2(m[h] - mnew);
    m[h] = mnew;
    float ps = 0.f;
#pragma unroll
    for (int kf = 0; kf < 4; ++kf)
#pragma unroll
      for (int r = 0; r < 4; ++r) {
        float pv = ex2(s[kf][h][r] - mnew);
        if (LANEMASK) pv = lv ? pv : 0.f;
        s[kf][h][r] = pv;
        ps += pv;
      }
    l[h] = l[h] * alpha + ps;
#pragma unroll
    for (int df = 0; df < 4; ++df) o[df][h] *= alpha;
  }
}

__device__ __forceinline__ void nsa_item(const P& p, int layer, int item, ldsp smem) {
  asm volatile("" : "+s"(layer));
  const int tid = tidx(), lane = tid & 63, w = tid >> 6, i = lane & 15, g = lane >> 4;
  const int sub = item & 7, b = sub >> 1, hp = sub & 1;
  const int rnk = (item & 511) >> 3;
  const int qt = item < 512 ? 127 - rnk : rnk;
  const int t0 = qt * 64;
  const int tl = t0 + 16 * w + i;
  const long rowl = (long)b * SEQ + tl;
  const long rowb = (long)b * SEQ;
  ldsp Ks = smem, Vs = smem + 9216, imp = smem + 18432, selm = smem + 52224, uni = smem + 53248, lst = smem + 53280;
  const bf16_t* kc = p.kcvc + (long)b * 512 * 64;
  const bf16_t* vc = p.kcvc + (long)2048 * 64 + (long)b * 512 * 64;
  __syncthreads();
  for (int e = tid; e < 64 * 132; e += 256) stsf(imp + e * 4, 0.f);
  const int nhi = (t0 + 32) >> 4;
  const int ncmp = (nhi > 510 ? 510 : nhi) / 64 + 1;
  float m4[4], inv4[4];
  {
    bf16x8 qf[4][2];
#pragma unroll
    for (int h = 0; h < 4; ++h)
#pragma unroll
      for (int ks = 0; ks < 2; ++ks)
        qf[h][ks] = __builtin_bit_cast(bf16x8, gld128(p.proj + rowl * NP + C_Q + h * 64 + 32 * ks + 8 * g));
    float l4[4];
#pragma unroll
    for (int h = 0; h < 4; ++h) { m4[h] = -1e30f; l4[h] = 0.f; }
    {
      u32x4 kr[2];
      stage64_ld(kr, kc, 64);
      for (int kt = 0; kt < ncmp; ++kt) {
        __syncthreads();
        stage64_st(kr, Ks);
        __syncthreads();
        if (kt + 1 < ncmp) stage64_ld(kr, kc + (long)(kt + 1) * 64 * 64, 64);
        f32x4 s[4][4];
        qk_tile<4>(s, Ks, qf, i, g);
        const bool cfull = ((kt * 64 + 63) * 16 + 31 <= t0) && (kt * 64 + 63 < 511);
        if (cfull) {
#pragma unroll
          for (int h = 0; h < 4; ++h) {
            float tmax = s[0][h][0];
#pragma unroll
            for (int kf = 0; kf < 4; ++kf)
#pragma unroll
              for (int r = 0; r < 4; ++r) tmax = fmaxf(tmax, s[kf][h][r]);
            tmax = fmaxf(tmax, __shfl_xor(tmax, 16));
            tmax = fmaxf(tmax, __shfl_xor(tmax, 32));
            float mnew = fmaxf(m4[h], tmax);
            float ps = 0.f;
#pragma unroll
            for (int kf = 0; kf < 4; ++kf)
#pragma unroll
              for (int r = 0; r < 4; ++r) ps += ex2(s[kf][h][r] - mnew);
            l4[h] = l4[h] * ex2(m4[h] - mnew) + ps;
            m4[h] = mnew;
          }
        } else {
#pragma unroll
        for (int h = 0; h < 4; ++h) {
          float tmax = -1e30f;
#pragma unroll
          for (int kf = 0; kf < 4; ++kf)
#pragma unroll
            for (int r = 0; r < 4; ++r) {
              int key = kt * 64 + 16 * kf + 4 * g + r;
              bool ok = (key * 16 + 31 <= tl) && key < 511;
              float v = ok ? s[kf][h][r] : -1e30f;
              s[kf][h][r] = v;
              tmax = fmaxf(tmax, v);
            }
          tmax = fmaxf(tmax, __shfl_xor(tmax, 16));
          tmax = fmaxf(tmax, __shfl_xor(tmax, 32));
          float mnew = fmaxf(m4[h], tmax);
          float ps = 0.f;
#pragma unroll
          for (int kf = 0; kf < 4; ++kf)
#pragma unroll
            for (int r = 0; r < 4; ++r) ps += (s[kf][h][r] > -1e29f) ? ex2(s[kf][h][r] - mnew) : 0.f;
          l4[h] = l4[h] * ex2(m4[h] - mnew) + ps;
          m4[h] = mnew;
        }
        }
      }
    }
#pragma unroll
    for (int h = 0; h < 4; ++h) {
      float lt = l4[h];
      lt += __shfl_xor(lt, 16);
      lt += __shfl_xor(lt, 32);
      inv4[h] = 1.f / fmaxf(lt, 1e-20f);
    }
    {
      u32x4 kr[2];
      stage64_ld(kr, kc, 64);
      for (int kt = 0; kt < ncmp; ++kt) {
        __syncthreads();
        stage64_st(kr, Ks);
        __syncthreads();
        if (kt + 1 < ncmp) stage64_ld(kr, kc + (long)(kt + 1) * 64 * 64, 64);
        f32x4 s[4][4];
        qk_tile<4>(s, Ks, qf, i, g);
        const bool cfull2 = ((kt * 64 + 63) * 16 + 31 <= t0) && (kt * 64 + 63 < 511);
        float mainv[4], spill[4];
#pragma unroll
        for (int kf = 0; kf < 4; ++kf) {
          mainv[kf] = 0.f; spill[kf] = 0.f;
#pragma unroll
          for (int r = 0; r < 4; ++r) {
            float pr = 0.f;
            if (cfull2) {
#pragma unroll
              for (int h = 0; h < 4; ++h) pr += ex2(s[kf][h][r] - m4[h]) * inv4[h];
            } else {
              int key = kt * 64 + 16 * kf + 4 * g + r;
              bool ok = (key * 16 + 31 <= tl) && key < 511;
#pragma unroll
              for (int h = 0; h < 4; ++h) pr += ok ? ex2(s[kf][h][r] - m4[h]) * inv4[h] : 0.f;
            }
            mainv[kf] += pr;
            if (r == 3) spill[kf] = pr;
          }
        }
        ldsp ir = imp + (16 * w + i) * 528;
#pragma unroll
        for (int kf = 0; kf < 4; ++kf) {
          int blk = 16 * kt + 4 * kf + g;
          stsf(ir + blk * 4, ldsf(ir + blk * 4) + mainv[kf]);
        }
#pragma unroll
        for (int kf = 0; kf < 4; ++kf) {
          int blk = 16 * kt + 4 * kf + g + 1;
          stsf(ir + blk * 4, ldsf(ir + blk * 4) + spill[kf]);
        }
      }
    }
  }
  __syncthreads();
  {
    int tok = tid >> 2, sb = tid & 3;
    unsigned mask = 0;
    const int cur = qt;
    ldsp ir = imp + tok * 528;
    if (cur < 16) {
      for (int j = 32 * sb; j < 32 * sb + 32; ++j)
        if (j <= cur) mask |= 1u << (j & 31);
    } else {
      float v[32];
#pragma unroll
      for (int q4 = 0; q4 < 8; ++q4) {
        f32x4 vv = *(LAS const f32x4*)(ir + (32 * sb + 4 * q4) * 4);
#pragma unroll
        for (int e = 0; e < 4; ++e) {
          int j = 32 * sb + 4 * q4 + e;
          v[4 * q4 + e] = (j >= 1 && j <= cur - 2) ? vv[e] : -INFINITY;
          if (j == 0 || (j > cur - 2 && j <= cur)) mask |= 1u << (j & 31);
        }
      }
#pragma unroll 1
      for (int round = 0; round < 13; ++round) {
        float bv = -INFINITY; int be = 0;
#pragma unroll
        for (int e = 0; e < 32; ++e) { bool gt_ = v[e] > bv; bv = gt_ ? v[e] : bv; be = gt_ ? e : be; }
        int bj = 32 * sb + be;
#pragma unroll
        for (int o = 1; o <= 2; o <<= 1) {
          float ov = __shfl_xor(bv, o); int oj = __shfl_xor(bj, o);
          bool take = (ov > bv) || (ov == bv && oj < bj);
          bv = take ? ov : bv; bj = take ? oj : bj;
        }
        if ((bj >> 5) == sb) {
          int e0 = bj & 31;
          mask |= 1u << e0;
#pragma unroll
          for (int e = 0; e < 32; ++e) v[e] = (e == e0) ? -INFINITY : v[e];
        }
      }
    }
    stsu(selm + (tok * 4 + sb) * 4, mask);
  }
  __syncthreads();
  if (w == 0) {
    unsigned a0 = ldsu(selm + (lane * 4 + 0) * 4), a1 = ldsu(selm + (lane * 4 + 1) * 4), a2 = ldsu(selm + (lane * 4 + 2) * 4), a3 = ldsu(selm + (lane * 4 + 3) * 4);
#pragma unroll
    for (int o = 32; o >= 1; o >>= 1) { a0 |= __shfl_xor(a0, o); a1 |= __shfl_xor(a1, o); a2 |= __shfl_xor(a2, o); a3 |= __shfl_xor(a3, o); }
    if (lane == 0) { stsu(uni, a0); stsu(uni + 4, a1); stsu(uni + 8, a2); stsu(uni + 12, a3); }
  }
  __syncthreads();
  if (tid < 128) {
    const unsigned u0 = ldsu(uni), u1 = ldsu(uni + 4), u2 = ldsu(uni + 8), u3 = ldsu(uni + 12);
    const int wd = tid >> 5, bp = tid & 31;
    const unsigned uw = wd == 0 ? u0 : (wd == 1 ? u1 : (wd == 2 ? u2 : u3));
    const int pos = (wd > 0 ? __popc(u0) : 0) + (wd > 1 ? __popc(u1) : 0) + (wd > 2 ? __popc(u2) : 0) + __popc(uw & ((1u << bp) - 1u));
    if ((uw >> bp) & 1u) stsu(lst + 4 + pos * 4, (unsigned)tid);
    if (tid == 0) stsu(lst, (unsigned)(__popc(u0) + __popc(u1) + __popc(u2) + __popc(u3)));
  }
  __syncthreads();
  const int nsel = __builtin_amdgcn_readfirstlane((int)ldsu(lst));
  unsigned mysel[4];
#pragma unroll
  for (int q = 0; q < 4; ++q) mysel[q] = ldsu(selm + ((16 * w + i) * 4 + q) * 4);
  {
    bf16x8 qf[2][2];
    float gt[2][3];
#pragma unroll
    for (int h = 0; h < 2; ++h) {
#pragma unroll
      for (int ks = 0; ks < 2; ++ks)
        qf[h][ks] = __builtin_bit_cast(bf16x8, gld128(p.proj + rowl * NP + C_Q + (2 * hp + h) * 64 + 32 * ks + 8 * g));
#pragma unroll
      for (int br = 0; br < 3; ++br) gt[h][br] = sigmf(bf2f(p.proj[rowl * NP + C_G + 3 * (2 * hp + h) + br]));
    }
    float mh[2], ih[2];
    mh[0] = hp ? m4[2] : m4[0]; mh[1] = hp ? m4[3] : m4[1];
    ih[0] = hp ? inv4[2] : inv4[0]; ih[1] = hp ? inv4[3] : inv4[1];
    f32x4 out[4][2];
#pragma unroll
    for (int df = 0; df < 4; ++df)
#pragma unroll
      for (int h = 0; h < 2; ++h) out[df][h] = (f32x4){0.f, 0.f, 0.f, 0.f};
    {
      u32x4 kr[2], vr[2];
      stage64_ld(kr, kc, 64);
      stage64_ld(vr, vc, 64);
      for (int kt = 0; kt < ncmp; ++kt) {
        __syncthreads();
        stage64_st(kr, Ks);
        stage64_st(vr, Vs);
        __syncthreads();
        if (kt + 1 < ncmp) {
          stage64_ld(kr, kc + (long)(kt + 1) * 64 * 64, 64);
          stage64_ld(vr, vc + (long)(kt + 1) * 64 * 64, 64);
        }
        f32x4 s[4][2];
        qk_tile<2>(s, Ks, qf, i, g);
        const bool cfull3 = ((kt * 64 + 63) * 16 + 31 <= t0) && (kt * 64 + 63 < 511);
        const float cg0 = ih[0] * gt[0][0], cg1 = ih[1] * gt[1][0];
#pragma unroll
        for (int kf = 0; kf < 4; ++kf)
#pragma unroll
          for (int r = 0; r < 4; ++r) {
            if (cfull3) {
              s[kf][0][r] = ex2(s[kf][0][r] - mh[0]) * cg0;
              s[kf][1][r] = ex2(s[kf][1][r] - mh[1]) * cg1;
            } else {
              int key = kt * 64 + 16 * kf + 4 * g + r;
              bool ok = (key * 16 + 31 <= tl) && key < 511;
              s[kf][0][r] = ok ? ex2(s[kf][0][r] - mh[0]) * cg0 : 0.f;
              s[kf][1][r] = ok ? ex2(s[kf][1][r] - mh[1]) * cg1 : 0.f;
            }
          }
        pv_tile(out, Vs, s, i, g);
      }
    }
#pragma unroll 1
    for (int br = 1; br < 3; ++br) {
      f32x4 o[4][2];
      float m[2], l[2];
#pragma unroll
      for (int h = 0; h < 2; ++h) {
        m[h] = -1e30f; l[h] = 0.f;
#pragma unroll
        for (int df = 0; df < 4; ++df) o[df][h] = (f32x4){0.f, 0.f, 0.f, 0.f};
      }
      const int jw0 = t0 >= 512 ? 0 : (512 - t0) >> 6;
      const int ntile = br == 1 ? nsel : 9 - jw0;
      const int kcol = br == 1 ? C_KS : C_KW, vcol = br == 1 ? C_VS : C_VW;
      auto tile_tok = [&](int idx) -> int {
        if (br == 1) return 64 * __builtin_amdgcn_readfirstlane((int)ldsu(lst + 4 + idx * 4));
        return t0 - 512 + 64 * (jw0 + idx);
      };
      u32x4 kr[2], vr[2];
      int ktn = tile_tok(0);
      stage64_ld(kr, p.proj + (rowb + ktn) * NP + kcol, NP);
      stage64_ld(vr, p.proj + (rowb + ktn) * NP + vcol, NP);
      for (int idx = 0; idx < ntile; ++idx) {
        const int kt0 = ktn;
        __syncthreads();
        stage64_st(kr, Ks);
        stage64_st(vr, Vs);
        __syncthreads();
        if (idx + 1 < ntile) {
          ktn = tile_tok(idx + 1);
          stage64_ld(kr, p.proj + (rowb + ktn) * NP + kcol, NP);
          stage64_ld(vr, p.proj + (rowb + ktn) * NP + vcol, NP);
        }
        bool selbit = true;
        if (br == 1) {
          int j = kt0 >> 6;
          unsigned mw = j < 32 ? mysel[0] : (j < 64 ? mysel[1] : (j < 96 ? mysel[2] : mysel[3]));
          selbit = (mw >> (j & 31)) & 1u;
        }
        if (br == 1 && !__any(selbit)) continue;
        f32x4 s[4][2];
        qk_tile<2>(s, Ks, qf, i, g);
        const bool full = (kt0 + 63 <= t0) && (br == 1 || kt0 >= t0 - 448);
        if (full) {
          if (br == 1) osm_update_full<true>(s, selbit, m, l, o);
          else osm_update_full<false>(s, true, m, l, o);
        } else {
          bool vm[4][4];
#pragma unroll
          for (int kf = 0; kf < 4; ++kf)
#pragma unroll
            for (int r = 0; r < 4; ++r) {
              int ktok = kt0 + 16 * kf + 4 * g + r;
              vm[kf][r] = br == 1 ? (selbit && ktok <= tl) : (ktok <= tl && ktok > tl - 512);
            }
          osm_update(s, vm, m, l, o);
        }
        pv_tile(o, Vs, s, i, g);
      }
#pragma unroll
      for (int h = 0; h < 2; ++h) {
        float lt = l[h];
        lt += __shfl_xor(lt, 16);
        lt += __shfl_xor(lt, 32);
        float cc = (br == 1 ? gt[h][1] : gt[h][2]) / fmaxf(lt, 1e-20f);
#pragma unroll
        for (int df = 0; df < 4; ++df) out[df][h] += o[df][h] * cc;
      }
    }
#pragma unroll
    for (int h = 0; h < 2; ++h)
#pragma unroll
      for (int df = 0; df < 4; ++df) {
        u32x2 ov;
        ov.x = pk2(out[df][h][0], out[df][h][1]);
        ov.y = pk2(out[df][h][2], out[df][h][3]);
        *(u32x2*)(p.ymix + slab_idx(rowl, 768 + (2 * hp + h) * 64 + 16 * df + 4 * g, NTOK)) = ov;
      }
  }
}

#define XB_TMO      128
#define XB_XCNT(j)  (256  + 64 * (j))
#define XB_XSUB(j)  (1280 + 64 * (j))
#define XB_XGEN(j)  (2304 + 64 * (j))
#define XB_TOP      3328
#define XB_TOPGEN   3392
#define XCD_BAR_WORDS 3456
#define XB_SPIN_CAP (1u << 22)
__device__ __forceinline__ unsigned xb_ld(unsigned* p) { return __hip_atomic_load(p, __ATOMIC_RELAXED, __HIP_MEMORY_SCOPE_AGENT); }
__device__ __forceinline__ unsigned xb_add(unsigned* p, unsigned v) { return __hip_atomic_fetch_add(p, v, __ATOMIC_RELAXED, __HIP_MEMORY_SCOPE_AGENT); }
__device__ __forceinline__ unsigned xb_xcc_id() { return (unsigned)__builtin_amdgcn_s_getreg((3 << 11) | 20) & 0xFu; }
#define XB_SPIN(cond, bar) do { unsigned _sp = 0; while (cond) { __builtin_amdgcn_s_sleep(1); \
    if ((++_sp & 255u) == 0u) { if (xb_ld(&(bar)[XB_TMO])) break; if (_sp > XB_SPIN_CAP) { atomicAdd(&(bar)[XB_TMO], 1u); break; } } } } while (0)
struct XcdBarrier { unsigned* bar; unsigned x; volatile LAS unsigned* st; };
__device__ __forceinline__ XcdBarrier xcd_barrier_post(unsigned* bar, volatile LAS unsigned* st) {
  XcdBarrier b; b.bar = bar; b.x = xb_xcc_id(); b.st = st;
  if (threadIdx.x == 0) (void)xb_add(&bar[XB_XCNT(b.x)], 1u);
  return b;
}
__device__ __forceinline__ void xcd_barrier_complete(unsigned* bar, unsigned x, unsigned& nloc, unsigned& nx) {
  const unsigned G = gridDim.x * gridDim.y * gridDim.z;
  unsigned sum, cnt, mine, sp = 0u;
  for (;;) {
    sum = 0u; cnt = 0u; mine = 0u;
#pragma unroll
    for (unsigned j = 0; j < 16; ++j) { const unsigned c = xb_ld(&bar[XB_XCNT(j)]); sum += c; cnt += (c > 0u) ? 1u : 0u; mine = (j == x) ? c : mine; }
    if (sum == G) break;
    __builtin_amdgcn_s_sleep(1);
    if ((++sp & 255u) == 0u) { if (xb_ld(&bar[XB_TMO])) break; if (sp > XB_SPIN_CAP) { atomicAdd(&bar[XB_TMO], 1u); break; } }
  }
  nloc = mine > 0u ? mine : 1u; nx = cnt > 0u ? cnt : 1u;
}
__device__ __forceinline__ void xcd_barrier(const XcdBarrier& b) {
  asm volatile("s_waitcnt vmcnt(0)" ::: "memory");
  __syncthreads();
  if (threadIdx.x == 0) {
    unsigned* bar = b.bar;
    __builtin_amdgcn_s_waitcnt(0);
    unsigned nloc = b.st[0], nx = b.st[1];
    if (nloc == 0u) { xcd_barrier_complete(bar, b.x, nloc, nx); b.st[0] = nloc; b.st[1] = nx; }
    const unsigned old = xb_add(&bar[XB_XSUB(b.x)], 1u);
    const unsigned gen = old / nloc;
    if (old + 1u == (gen + 1u) * nloc) {
      __builtin_amdgcn_fence(__ATOMIC_RELEASE, "agent");
      asm volatile("s_waitcnt vmcnt(0)" ::: "memory");
      const unsigned og = xb_add(&bar[XB_TOP], 1u);
      const unsigned tg = og / nx;
      if (og + 1u == (tg + 1u) * nx) xb_add(&bar[XB_TOPGEN], 1u);
      else XB_SPIN(xb_ld(&bar[XB_TOPGEN]) == tg, bar);
      __builtin_amdgcn_fence(__ATOMIC_ACQUIRE, "agent");
      xb_add(&bar[XB_XGEN(b.x)], 1u);
      asm volatile("s_waitcnt vmcnt(0)" ::: "memory");
    } else {
      XB_SPIN(xb_ld(&bar[XB_XGEN(b.x)]) == gen, bar);
      __builtin_amdgcn_fence(__ATOMIC_ACQUIRE, "agent");
      asm volatile("s_waitcnt vmcnt(0)" ::: "memory");
    }
  }
  __syncthreads();
}

enum { PH_CONV = 0, PH_INPROJ, PH_MIX1, PH_MIX2, PH_MIX3, PH_OUTPROJ, PH_UP, PH_DOWN, PH_FINAL };

__device__ __forceinline__ void run_phase(const P& p, int ph, int layer, ldsp smem) {
  switch (ph) {
    case PH_CONV: ph_convert(p, smem); ph_prepass(p); break;
    case PH_INPROJ: ph_inproj(p, layer, smem); break;
    case PH_MIX1:
      if (gridDim.x > 64) {
        if (blockIdx.x < 32) cmp_gemm1_tile(p, layer, blockIdx.x, smem);
        else for (int it = blockIdx.x - 32; it < 1024; it += gridDim.x - 32) ssd1_item(p, layer, it, smem);
      } else {
        for (int it = blockIdx.x; it < 32; it += gridDim.x) cmp_gemm1_tile(p, layer, it, smem);
        for (int it = blockIdx.x; it < 1024; it += gridDim.x) ssd1_item(p, layer, it, smem);
      }
      for (int it = blockIdx.x; it < 512; it += gridDim.x) shortconv_item(p, layer, it);
      break;
    case PH_MIX2:
      for (int it = blockIdx.x; it < 512; it += gridDim.x) ssd2_item(p, it);
      for (int it = blockIdx.x; it < 1024; it += gridDim.x) cmp_gemm2_item(p, layer, it);
      break;
    case PH_MIX3:
      for (int it = blockIdx.x; it < 1024; it += gridDim.x) nsa_item(p, layer, it, smem);
      for (int it = blockIdx.x; it < 512; it += gridDim.x) ssd3_item(p, layer, it, smem);
      break;
    case PH_OUTPROJ: ph_resgemm(p.ymix, DM, p.WoutT + (long)layer * DM * DM, p.h, p.ssqp, smem); break;
    case PH_UP: ph_ffn_up(p, layer, smem); break;
    case PH_DOWN: ph_resgemm(p.act, DFF, p.WdownT + (long)layer * DM * DFF, p.h, p.ssqp, smem); break;
    case PH_FINAL: ph_final(p); break;
  }
}

#if SINGLE_LAUNCH
__global__ void __launch_bounds__(256, 2) k_all(P p) {
  extern __shared__ __attribute__((aligned(16))) unsigned char lds_raw[];
  ldsp smem = (ldsp)lds_raw;
  cg::grid_group grid = cg::this_grid();
  volatile LAS unsigned* st = (volatile LAS unsigned*)(smem + LDS_MAIN);
  if (threadIdx.x < 4) st[threadIdx.x] = 0u;
  __syncthreads();
  XcdBarrier xb = xcd_barrier_post(p.bar, st);
  constexpr int NSTEP = 2 + NLAYER * 7;
  for (int step = 0; step < NSTEP; ++step) {
    int ph, layer;
    if (step == 0) { ph = PH_CONV; layer = 0; }
    else if (step == NSTEP - 1) { ph = PH_FINAL; layer = 0; }
    else { layer = (step - 1) / 7; ph = PH_INPROJ + (step - 1) % 7; }
    const int reps = (ph == REP_PH) ? 2 : 1;
    for (int r = 0; r < reps; ++r) run_phase(p, ph, layer, smem);
    if (step == 0) grid.sync();
    else if (step + 1 < NSTEP) xcd_barrier(xb);
  }
}
#define KMAIN k_all
#else
__global__ void __launch_bounds__(256, 2) k_phase(P p, int ph, int layer) {
  extern __shared__ __attribute__((aligned(16))) unsigned char lds_raw[];
  run_phase(p, ph, layer, (ldsp)lds_raw);
}
#define KMAIN k_phase
#endif

extern "C" void kernel_launch(void* const* d_in, const int* in_sizes, int n_in, void* d_out, int out_size, void* d_ws,
                              size_t ws_size, hipStream_t stream) {
  static int grid_blocks = 0;
  if (!grid_blocks) {
    int dev = 0, cus = 0, per_cu = 0;
    (void)hipGetDevice(&dev);
    (void)hipDeviceGetAttribute(&cus, hipDeviceAttributeMultiprocessorCount, dev);
    (void)hipFuncSetAttribute((const void*)KMAIN, hipFuncAttributeMaxDynamicSharedMemorySize, LDS_BYTES);
    (void)hipOccupancyMaxActiveBlocksPerMultiprocessor(&per_cu, (const void*)KMAIN, 256, LDS_BYTES);
    if (per_cu < 1) per_cu = 1;
    if (per_cu > 2) per_cu = 2;
    grid_blocks = cus * per_cu;
  }
  P p{};
  const float** pin = (const float**)&p;
  for (int q = 0; q < 23; ++q) pin[q] = (const float*)d_in[q];
  p.out = (float*)d_out;
  unsigned char* ws = (unsigned char*)d_ws;
  size_t off = 0;
  auto take = [&](size_t bytes) { unsigned char* r = ws + off; off += (bytes + 255) & ~(size_t)255; return r; };
  p.WinT = (bf16_t*)take((size_t)NLAYER * NP * DM * 2);
  p.WoutT = (bf16_t*)take((size_t)NLAYER * DM * DM * 2);
  p.WupT = (bf16_t*)take((size_t)NLAYER * 5632 * DM * 2);
  p.WdownT = (bf16_t*)take((size_t)NLAYER * DM * DFF * 2);
  p.W1T = (bf16_t*)take((size_t)NLAYER * 2 * 128 * 2048 * 2);
  p.zeros = (bf16_t*)take(4096);
  p.cwh = (bf16_t*)take((size_t)NLAYER * 5 * 1024 * 2);
  p.c1 = (float*)take(NLAYER * 2 * 128 * 4);
  p.rope = (float*)take((size_t)SEQ * 64 * 4);
  p.cdec = (float*)take(4 * 128 * 8 * 4);
  p.bar = (unsigned*)take(XCD_BAR_WORDS * 4);
  p.ssqp = (float*)take((size_t)NTOK * 8 * 4);
  p.hid = (bf16_t*)take((size_t)2 * 2048 * 128 * 2);
  p.kcvc = (bf16_t*)take((size_t)2 * 2048 * 64 * 2);
  p.h = (bf16_t*)take((size_t)NTOK * DM * 2);
  p.states = (bf16_t*)take((size_t)NTOK * DM * 2);
  p.proj = (bf16_t*)take((size_t)NTOK * NP * 2);
  p.act = p.proj;
  p.ymix = (bf16_t*)take((size_t)NTOK * DM * 2);
  if (off > ws_size) { fprintf(stderr, "workspace too small: need %zu have %zu\n", off, ws_size); return; }
#if SINGLE_LAUNCH
  (void)hipMemsetAsync(p.bar, 0, XCD_BAR_WORDS * 4, stream);
  void* args[] = {&p};
  hipError_t e = hipLaunchCooperativeKernel((const void*)k_all, dim3(grid_blocks), dim3(256), args, LDS_BYTES, stream);
  if (e != hipSuccess) fprintf(stderr, "cooperative launch failed: %s (grid %d)\n", hipGetErrorString(e), grid_blocks);
#else
  k_phase<<<grid_blocks, 256, LDS_BYTES, stream>>>(p, PH_CONV, 0);
  for (int layer = 0; layer < NLAYER; ++layer)
    for (int ph = PH_INPROJ; ph <= PH_DOWN; ++ph) k_phase<<<grid_blocks, 256, LDS_BYTES, stream>>>(p, ph, layer);
  k_phase<<<grid_blocks, 256, LDS_BYTES, stream>>>(p, PH_FINAL, 0);
#endif
}
```

```cpp
#include <hip/hip_runtime.h>
#include <hip/hip_cooperative_groups.h>
#include <cstdio>
namespace cg = cooperative_groups;

#ifndef REP_PH
#define REP_PH -1
#endif
#ifndef SINGLE_LAUNCH
#define SINGLE_LAUNCH 1
#endif

typedef unsigned short bf16_t;
typedef short bf16x8 __attribute__((ext_vector_type(8)));
typedef short s16x4 __attribute__((ext_vector_type(4)));
typedef short v4i16_t __attribute__((ext_vector_type(4)));
typedef float f32x4 __attribute__((ext_vector_type(4)));
typedef unsigned u32x4 __attribute__((ext_vector_type(4)));
typedef unsigned u32x2 __attribute__((ext_vector_type(2)));
#define LAS __attribute__((address_space(3)))
typedef LAS unsigned char* ldsp;

constexpr int NTOK = 32768, SEQ = 8192, DM = 1024, NP = 3072, DFF = 2752, NLAYER = 4;
constexpr int LDS_MAIN = 73728;
constexpr int LDS_BYTES = LDS_MAIN + 16;
constexpr int C_Z = 0, C_XBC = 512, C_SCB = 1536, C_SCC = 1792, C_SCH = 2048, C_Q = 2304, C_KC = 2560, C_VC = 2624,
              C_KS = 2688, C_VS = 2752, C_KW = 2816, C_VW = 2880, C_DT = 2944, C_G = 2952;

struct P {
  const float *x, *attn_norm_w, *w_in, *ssd_conv_w, *ssd_conv_b, *ssd_dt_bias, *ssd_a_log, *ssd_d, *ssd_norm_w, *sc_conv_w,
      *cmp_k_pos, *cmp_k_w1, *cmp_k_w2, *cmp_v_pos, *cmp_v_w1, *cmp_v_w2, *w_out, *ffn_norm_w, *ffn_w_up, *ffn_conv_w,
      *ffn_conv_b, *ffn_w_down, *final_norm_w;
  float* out;
  bf16_t *WinT, *WoutT, *WupT, *WdownT, *W1T, *zeros, *h, *proj, *ymix, *act, *states, *hid, *kcvc;
  float *c1, *rope, *cdec, *ssqp;
  unsigned* bar;
  bf16_t* cwh;
};

__device__ __forceinline__ int tidx() { int t = threadIdx.x; asm volatile("" : "+v"(t)); return t; }
typedef _Float16 h16x8 __attribute__((ext_vector_type(8)));
typedef _Float16 h16x2 __attribute__((ext_vector_type(2)));
__device__ __forceinline__ bf16_t f2bf(float f) { _Float16 h = (_Float16)f; return __builtin_bit_cast(unsigned short, h); }
__device__ __forceinline__ float bf2f(bf16_t b) { return (float)__builtin_bit_cast(_Float16, b); }
__device__ __forceinline__ unsigned pk2(float a, float b) { return __builtin_bit_cast(unsigned, __builtin_amdgcn_cvt_pkrtz(a, b)); }
__device__ __forceinline__ h16x2 as_h2(unsigned u) { return __builtin_bit_cast(h16x2, u); }
__device__ __forceinline__ float bflo(unsigned u) { return (float)__builtin_bit_cast(h16x2, u).x; }
__device__ __forceinline__ float bfhi(unsigned u) { return (float)__builtin_bit_cast(h16x2, u).y; }
__device__ __forceinline__ bf16x8 pack8(const float* v) {
  u32x4 u;
  u.x = pk2(v[0], v[1]); u.y = pk2(v[2], v[3]); u.z = pk2(v[4], v[5]); u.w = pk2(v[6], v[7]);
  return __builtin_bit_cast(bf16x8, u);
}
__device__ __forceinline__ bf16x8 pack44(f32x4 a, f32x4 b) {
  u32x4 u;
  u.x = pk2(a[0], a[1]); u.y = pk2(a[2], a[3]); u.z = pk2(b[0], b[1]); u.w = pk2(b[2], b[3]);
  return __builtin_bit_cast(bf16x8, u);
}
__device__ __forceinline__ bf16x8 pack44_rtz(f32x4 a, f32x4 b) {
  u32x4 u;
  u.x = __builtin_bit_cast(unsigned, __builtin_amdgcn_cvt_pkrtz(a[0], a[1])); u.y = __builtin_bit_cast(unsigned, __builtin_amdgcn_cvt_pkrtz(a[2], a[3]));
  u.z = __builtin_bit_cast(unsigned, __builtin_amdgcn_cvt_pkrtz(b[0], b[1])); u.w = __builtin_bit_cast(unsigned, __builtin_amdgcn_cvt_pkrtz(b[2], b[3]));
  return __builtin_bit_cast(bf16x8, u);
}
__device__ __forceinline__ void unpack8(u32x4 u, float* v) {
  v[0] = bflo(u.x); v[1] = bfhi(u.x); v[2] = bflo(u.y); v[3] = bfhi(u.y);
  v[4] = bflo(u.z); v[5] = bfhi(u.z); v[6] = bflo(u.w); v[7] = bfhi(u.w);
}
__device__ __forceinline__ bf16x8 ld128(ldsp p) { return *(LAS const bf16x8*)p; }
__device__ __forceinline__ void st128(ldsp p, u32x4 v) { *(LAS u32x4*)p = v; }
__device__ __forceinline__ s16x4 ldtr(ldsp p) {
  return __builtin_bit_cast(s16x4, __builtin_amdgcn_ds_read_tr16_b64_v4i16((LAS v4i16_t*)p));
}
__device__ __forceinline__ bf16x8 cat4(s16x4 a, s16x4 b) {
  bf16x8 r;
  r[0] = a[0]; r[1] = a[1]; r[2] = a[2]; r[3] = a[3]; r[4] = b[0]; r[5] = b[1]; r[6] = b[2]; r[7] = b[3];
  return r;
}
__device__ __forceinline__ float ldsf(ldsp p) { return *(LAS const float*)p; }
__device__ __forceinline__ unsigned ldsu(ldsp p) { return *(LAS const unsigned*)p; }
__device__ __forceinline__ void stsf(ldsp p, float v) { *(LAS float*)p = v; }
__device__ __forceinline__ void stsu(ldsp p, unsigned v) { *(LAS unsigned*)p = v; }
__device__ __forceinline__ f32x4 mfma16(bf16x8 a, bf16x8 b, f32x4 c) {
  return __builtin_amdgcn_mfma_f32_16x16x32_f16(__builtin_bit_cast(h16x8, a), __builtin_bit_cast(h16x8, b), c, 0, 0, 0);
}
__device__ __forceinline__ float ex2(float x) { return __builtin_amdgcn_exp2f(x); }
__device__ __forceinline__ float siluf(float x) { return x * __builtin_amdgcn_rcpf(1.f + __expf(-x)); }
__device__ __forceinline__ float sigmf(float x) { return __builtin_amdgcn_rcpf(1.f + __expf(-x)); }
__device__ __forceinline__ float softplusf(float x) { return x > 20.f ? x : log1pf(expf(x)); }
__device__ __forceinline__ float geluf(float x) {
  float u = 0.7978845608028654f * (x + 0.044715f * x * x * x);
  return 0.5f * x * (1.f + tanhf(u));
}
__device__ __forceinline__ u32x4 gld128(const bf16_t* p) { return *(const u32x4*)p; }
__device__ __forceinline__ long slab_idx(long row, int col, long nrows) { return ((long)(col >> 5) * nrows + row) * 32 + (col & 31); }

__device__ __forceinline__ int map_win(int n) {
  if (n < 1536) return n;
  if (n < 2944) return n + 8;
  if (n < 2952) return n - 2944 + 1536;
  if (n < 2964) return n;
  return -1;
}
__device__ __forceinline__ int map_wup(int n) {
  int j = n >> 7, r = n & 127;
  if (j >= 43) return -1;
  return r < 64 ? 64 * j + r : DFF + 64 * j + (r - 64);
}
__device__ __forceinline__ void transpose_tile(const float* src, int Nsrc, bf16_t* dst, int Ndst, int n0, int k0, int kind, ldsp smem,
                                               const float* kscale = nullptr) {
  const int tid = tidx();
  __syncthreads();
  {
    int nn = tid & 63;
    int n = n0 + nn;
    int sc = kind == 0 ? n : (kind == 1 ? map_win(n) : map_wup(n));
    for (int it = 0; it < 16; ++it) {
      int k = it * 4 + (tid >> 6);
      float v = sc >= 0 ? src[(long)(k0 + k) * Nsrc + sc] : 0.f;
      if (kscale) v *= kscale[k0 + k];
      stsf(smem + (k * 65 + nn) * 4, v);
    }
  }
  __syncthreads();
  {
    int nn = tid >> 2, kc = (tid & 3) * 16;
    float v[16];
    for (int e = 0; e < 16; ++e) v[e] = ldsf(smem + ((kc + e) * 65 + nn) * 4);
    u32x4 a, b;
    a.x = pk2(v[0], v[1]); a.y = pk2(v[2], v[3]); a.z = pk2(v[4], v[5]); a.w = pk2(v[6], v[7]);
    b.x = pk2(v[8], v[9]); b.y = pk2(v[10], v[11]); b.z = pk2(v[12], v[13]); b.w = pk2(v[14], v[15]);
    bf16_t* d = dst + slab_idx(n0 + nn, k0 + kc, Ndst);
    *(u32x4*)d = a;
    *(u32x4*)(d + 8) = b;
  }
}

constexpr int CV_WIN = 48 * 16, CV_WOUT = 16 * 16, CV_WUP = 88 * 16, CV_WDN = 16 * 43, CV_W1 = 2 * 32;
constexpr int CV_LAYER = CV_WIN + CV_WOUT + CV_WUP + CV_WDN + 2 * CV_W1;
constexpr int CV_ROPE = 1024, CV_C1 = 8, CV_TOTAL = NLAYER * CV_LAYER + CV_ROPE + CV_C1 + 1;

struct TDesc { const float* src; const float* kscale; bf16_t* dst; int Nsrc, Ndst, n0, k0, kind; };
__device__ __forceinline__ TDesc conv_desc(const P& p, int it) {
  TDesc d; d.kscale = nullptr; d.kind = 0;
  int l = it / CV_LAYER, r = it % CV_LAYER;
  if (r < CV_WIN) {
    d.src = p.w_in + (long)l * DM * 2964; d.Nsrc = 2964; d.dst = p.WinT + (long)l * NP * DM; d.Ndst = NP; d.n0 = (r / 16) * 64; d.k0 = (r % 16) * 64; d.kind = 1; d.kscale = p.attn_norm_w + l * DM;
  } else if ((r -= CV_WIN) < CV_WOUT) {
    d.src = p.w_out + (long)l * DM * DM; d.Nsrc = DM; d.dst = p.WoutT + (long)l * DM * DM; d.Ndst = DM; d.n0 = (r / 16) * 64; d.k0 = (r % 16) * 64;
  } else if ((r -= CV_WOUT) < CV_WUP) {
    d.src = p.ffn_w_up + (long)l * DM * 2 * DFF; d.Nsrc = 2 * DFF; d.dst = p.WupT + (long)l * 5632 * DM; d.Ndst = 5632; d.n0 = (r / 16) * 64; d.k0 = (r % 16) * 64; d.kind = 2; d.kscale = p.ffn_norm_w + l * DM;
  } else if ((r -= CV_WUP) < CV_WDN) {
    d.src = p.ffn_w_down + (long)l * DFF * DM; d.Nsrc = DM; d.dst = p.WdownT + (long)l * DM * DFF; d.Ndst = DM; d.n0 = (r / 43) * 64; d.k0 = (r % 43) * 64;
  } else if ((r -= CV_WDN) < CV_W1) {
    d.src = p.cmp_k_w1 + (long)l * 2048 * 128; d.Nsrc = 128; d.dst = p.W1T + (long)(l * 2 + 0) * 128 * 2048; d.Ndst = 128; d.n0 = (r / 32) * 64; d.k0 = (r % 32) * 64;
  } else {
    r -= CV_W1;
    d.src = p.cmp_v_w1 + (long)l * 2048 * 128; d.Nsrc = 128; d.dst = p.W1T + (long)(l * 2 + 1) * 128 * 2048; d.Ndst = 128; d.n0 = (r / 32) * 64; d.k0 = (r % 32) * 64;
  }
  return d;
}
__device__ __forceinline__ void transpose_group4(const P& p, int it0, ldsp smem) {
  const int tid = tidx();
  const int n4 = (tid & 15) * 4, kr = tid >> 4;
  float4 v[4][4];
  TDesc d[4];
#pragma unroll
  for (int t = 0; t < 4; ++t) {
    d[t] = conv_desc(p, it0 + t);
    const int n = d[t].n0 + n4;
    const int sc = d[t].kind == 0 ? n : (d[t].kind == 1 ? map_win(n) : map_wup(n));
#pragma unroll
    for (int q = 0; q < 4; ++q) {
      const int k = d[t].k0 + kr + 16 * q;
      v[t][q] = sc >= 0 ? *(const float4*)(d[t].src + (long)k * d[t].Nsrc + sc) : make_float4(0.f, 0.f, 0.f, 0.f);
      if (d[t].kscale) { const float ks = d[t].kscale[k]; v[t][q].x *= ks; v[t][q].y *= ks; v[t][q].z *= ks; v[t][q].w *= ks; }
    }
  }
  __syncthreads();
#pragma unroll
  for (int t = 0; t < 4; ++t)
#pragma unroll
    for (int q = 0; q < 4; ++q) {
      const ldsp b = smem + t * 16640 + ((kr + 16 * q) * 65 + n4) * 4;
      stsf(b, v[t][q].x); stsf(b + 4, v[t][q].y); stsf(b + 8, v[t][q].z); stsf(b + 12, v[t][q].w);
    }
  __syncthreads();
#pragma unroll
  for (int t = 0; t < 4; ++t) {
    const int nn = tid >> 2, kc = (tid & 3) * 16;
    float w[16];
#pragma unroll
    for (int e = 0; e < 16; ++e) w[e] = ldsf(smem + t * 16640 + ((kc + e) * 65 + nn) * 4);
    u32x4 a, b;
    a.x = pk2(w[0], w[1]); a.y = pk2(w[2], w[3]); a.z = pk2(w[4], w[5]); a.w = pk2(w[6], w[7]);
    b.x = pk2(w[8], w[9]); b.y = pk2(w[10], w[11]); b.z = pk2(w[12], w[13]); b.w = pk2(w[14], w[15]);
    bf16_t* dp = d[t].dst + slab_idx(d[t].n0 + nn, d[t].k0 + kc, d[t].Ndst);
    *(u32x4*)dp = a;
    *(u32x4*)(dp + 8) = b;
  }
}
__device__ __forceinline__ void ph_convert(const P& p, ldsp smem) {
  const int tid = tidx();
  for (int gi = blockIdx.x; gi < NLAYER * CV_LAYER / 4; gi += gridDim.x) transpose_group4(p, gi * 4, smem);
  for (int it = NLAYER * CV_LAYER + blockIdx.x; it < CV_TOTAL; it += gridDim.x) {
    if (it < NLAYER * CV_LAYER) {
      int l = it / CV_LAYER, r = it % CV_LAYER;
      if (r < CV_WIN) {
        transpose_tile(p.w_in + (long)l * DM * 2964, 2964, p.WinT + (long)l * NP * DM, NP, (r / 16) * 64, (r % 16) * 64, 1, smem, p.attn_norm_w + l * DM);
      } else if ((r -= CV_WIN) < CV_WOUT) {
        transpose_tile(p.w_out + (long)l * DM * DM, DM, p.WoutT + (long)l * DM * DM, DM, (r / 16) * 64, (r % 16) * 64, 0, smem);
      } else if ((r -= CV_WOUT) < CV_WUP) {
        transpose_tile(p.ffn_w_up + (long)l * DM * 2 * DFF, 2 * DFF, p.WupT + (long)l * 5632 * DM, 5632, (r / 16) * 64, (r % 16) * 64, 2, smem, p.ffn_norm_w + l * DM);
      } else if ((r -= CV_WUP) < CV_WDN) {
        transpose_tile(p.ffn_w_down + (long)l * DFF * DM, DM, p.WdownT + (long)l * DM * DFF, DM, (r / 43) * 64, (r % 43) * 64, 0, smem);
      } else if ((r -= CV_WDN) < CV_W1) {
        transpose_tile(p.cmp_k_w1 + (long)l * 2048 * 128, 128, p.W1T + (long)(l * 2 + 0) * 128 * 2048, 128, (r / 32) * 64, (r % 32) * 64, 0, smem);
      } else {
        r -= CV_W1;
        transpose_tile(p.cmp_v_w1 + (long)l * 2048 * 128, 128, p.W1T + (long)(l * 2 + 1) * 128 * 2048, 128, (r / 32) * 64, (r % 32) * 64, 0, smem);
      }
    } else {
      int r = it - NLAYER * CV_LAYER;
      if (r < CV_ROPE) {
        int idx = r * 256 + tid;
        int t = idx >> 5, d = idx & 31;
        float inv = 1.0f / powf(10000.0f, (float)d / 32.0f);
        float ang = (float)t * inv;
        p.rope[t * 64 + d] = cosf(ang);
        p.rope[t * 64 + 32 + d] = sinf(ang);
      } else if ((r -= CV_ROPE) < CV_C1) {
        int l = r >> 1, kv = r & 1;
        const float* pos = (kv ? p.cmp_v_pos : p.cmp_k_pos) + (long)l * 2048;
        const float* w1 = (kv ? p.cmp_v_w1 : p.cmp_k_w1) + (long)l * 2048 * 128;
        const int n4 = (tid & 31) * 4, kg = tid >> 5;
        float4 ac = make_float4(0.f, 0.f, 0.f, 0.f);
#pragma unroll 8
        for (int k = kg * 256; k < kg * 256 + 256; ++k) {
          const float pk = pos[k];
          const float4 wv4 = *(const float4*)(w1 + (long)k * 128 + n4);
          ac.x += pk * wv4.x; ac.y += pk * wv4.y; ac.z += pk * wv4.z; ac.w += pk * wv4.w;
        }
        __syncthreads();
        stsf(smem + (kg * 128 + n4) * 4, ac.x); stsf(smem + (kg * 128 + n4 + 1) * 4, ac.y);
        stsf(smem + (kg * 128 + n4 + 2) * 4, ac.z); stsf(smem + (kg * 128 + n4 + 3) * 4, ac.w);
        __syncthreads();
        if (tid < 128) {
          float sacc = 0.f;
#pragma unroll
          for (int gq = 0; gq < 8; ++gq) sacc += ldsf(smem + (gq * 128 + tid) * 4);
          p.c1[(l * 2 + kv) * 128 + tid] = sacc;
        }
      } else {
        for (int e = tid; e < 2048; e += 256) p.zeros[e] = 0;
        for (int e2 = tid; e2 < NLAYER * 5 * 512; e2 += 256) {
          const int e = 2 * e2, l2 = e / 5120, r2 = (e % 5120) >> 10, c2 = e & 1023;
          const float* src = r2 < 4 ? p.ssd_conv_w + (long)l2 * 4096 + r2 * 1024 + c2 : p.ssd_conv_b + l2 * 1024 + c2;
          ((unsigned*)p.cwh)[e2] = pk2(src[0], src[1]);
        }
      }
    }
  }
}

__device__ __forceinline__ void ph_prepass(const P& p) {
  const int wave = tidx() >> 6, lane = tidx() & 63;
  for (int row = blockIdx.x * 4 + wave; row < NTOK; row += gridDim.x * 4) {
    const float4* xr = (const float4*)(p.x + (long)row * DM);
    float ss = 0.f;
#pragma unroll
    for (int k = 0; k < 4; ++k) {
      float4 v = xr[lane + 64 * k];
      ss += v.x * v.x + v.y * v.y + v.z * v.z + v.w * v.w;
      u32x2 o; o.x = pk2(v.x, v.y); o.y = pk2(v.z, v.w);
      *(u32x2*)(p.h + slab_idx(row, (lane + 64 * k) * 4, NTOK)) = o;
    }
#pragma unroll
    for (int o = 32; o >= 1; o >>= 1) ss += __shfl_xor(ss, o);
    if (lane < 8) p.ssqp[(long)row * 8 + lane] = lane == 0 ? ss : 0.f;
  }
}
__device__ __forceinline__ float row_rstd(const float* ssqp, long row) {
  float4 a = *(const float4*)(ssqp + row * 8), b = *(const float4*)(ssqp + row * 8 + 4);
  float ss = ((a.x + a.y) + (a.z + a.w)) + ((b.x + b.y) + (b.z + b.w));
  return rsqrtf(ss * (1.f / 1024.f) + 1e-6f);
}
__device__ __forceinline__ void ph_final(const P& p) {
  const int wave = tidx() >> 6, lane = tidx() & 63;
  for (int row = blockIdx.x * 4 + wave; row < NTOK; row += gridDim.x * 4) {
    float4 v[4];
    float ss = 0.f;
#pragma unroll
    for (int k = 0; k < 4; ++k) {
      u32x2 hv = *(const u32x2*)(p.h + slab_idx(row, (lane + 64 * k) * 4, NTOK));
      v[k].x = bflo(hv.x); v[k].y = bfhi(hv.x); v[k].z = bflo(hv.y); v[k].w = bfhi(hv.y);
      ss += v[k].x * v[k].x + v[k].y * v[k].y + v[k].z * v[k].z + v[k].w * v[k].w;
    }
#pragma unroll
    for (int o = 32; o >= 1; o >>= 1) ss += __shfl_xor(ss, o);
    const float rstd = rsqrtf(ss * (1.f / 1024.f) + 1e-6f);
#pragma unroll
    for (int k = 0; k < 4; ++k) {
      float4 w4 = ((const float4*)p.final_norm_w)[lane + 64 * k];
      float4 o; o.x = v[k].x * rstd * w4.x; o.y = v[k].y * rstd * w4.y; o.z = v[k].z * rstd * w4.z; o.w = v[k].w * rstd * w4.w;
      ((float4*)(p.out + (long)row * DM))[lane + 64 * k] = o;
    }
  }
}
__device__ __forceinline__ void ph_rmsnorm(const float* x, const float* w, bf16_t* h, float* outf) {
  const int wave = tidx() >> 6, lane = tidx() & 63;
  for (int row = blockIdx.x * 4 + wave; row < NTOK; row += gridDim.x * 4) {
    const float4* xr = (const float4*)(x + (long)row * DM);
    float4 v[4];
    float ss = 0.f;
#pragma unroll
    for (int k = 0; k < 4; ++k) {
      v[k] = xr[lane + 64 * k];
      ss += v[k].x * v[k].x + v[k].y * v[k].y + v[k].z * v[k].z + v[k].w * v[k].w;
    }
#pragma unroll
    for (int o = 32; o >= 1; o >>= 1) ss += __shfl_xor(ss, o);
    float rstd = rsqrtf(ss * (1.f / 1024.f) + 1e-6f);
#pragma unroll
    for (int k = 0; k < 4; ++k) {
      float4 w4 = ((const float4*)w)[lane + 64 * k];
      float a = v[k].x * rstd * w4.x, b = v[k].y * rstd * w4.y, c = v[k].z * rstd * w4.z, d = v[k].w * rstd * w4.w;
      if (h) {
        u32x2 o; o.x = pk2(a, b); o.y = pk2(c, d);
        *(u32x2*)(h + slab_idx(row, (lane + 64 * k) * 4, NTOK)) = o;
      } else {
        float4 o; o.x = a; o.y = b; o.z = c; o.w = d;
        ((float4*)(outf + (long)row * DM))[lane + 64 * k] = o;
      }
    }
  }
}

constexpr int GSTAGE = 24576;
__device__ __forceinline__ int gemm_chunk_off() {
  const int t = tidx();
  const int sq = (t >> 4) & 3;
  const int sv = (0x78 >> (2 * sq)) & 3;
  return ((t & 3) ^ sv) * 8;
}
__device__ __forceinline__ const char* uniform_ptr(const char* p) {
  unsigned long long v = (unsigned long long)p;
  unsigned lo = __builtin_amdgcn_readfirstlane((unsigned)v), hi = __builtin_amdgcn_readfirstlane((unsigned)(v >> 32));
  asm volatile("" : "+s"(lo), "+s"(hi));
  return (const char*)(((unsigned long long)hi << 32) | lo);
}
template <bool CMPA>
__device__ __forceinline__ void gemm_core(f32x4 (&acc)[8][4], const char* abase, const unsigned (&voffA)[2], size_t astep, const char* bbase,
                                          const unsigned (&voffB)[4], size_t bstep, int nk, ldsp smem) {
  const int tid = tidx(), lane = tid & 63, wid = tid >> 6, wr = wid >> 1, wc = wid & 1, i = lane & 15, g = lane >> 4;
#pragma unroll
  for (int nf = 0; nf < 8; ++nf)
#pragma unroll
    for (int mf = 0; mf < 4; ++mf) acc[nf][mf] = (f32x4){0.f, 0.f, 0.f, 0.f};
  asm volatile("s_waitcnt vmcnt(0)" ::: "memory");
  __syncthreads();
  const int wbase = __builtin_amdgcn_readfirstlane(tid >> 6) * 1024;
  auto stage = [&](int kt, int buf) {
    const char* ak = uniform_ptr(abase + (CMPA ? ((size_t)(kt >> 1) * NP + (kt & 1) * 32) * 2 : (size_t)kt * astep));
    const char* bk = uniform_ptr(bbase + (size_t)kt * bstep);
#pragma unroll
    for (int q = 0; q < 2; ++q)
      __builtin_amdgcn_global_load_lds((const unsigned*)(ak + voffA[q]), (LAS unsigned*)(smem + buf * GSTAGE + wbase + q * 4096), 16, 0, 0);
#pragma unroll
    for (int q = 0; q < 4; ++q)
      __builtin_amdgcn_global_load_lds((const unsigned*)(bk + voffB[q]), (LAS unsigned*)(smem + buf * GSTAGE + 8192 + wbase + q * 4096), 16, 0, 0);
  };
  stage(0, 0);
  if (nk > 1) stage(1, 1);
  const int sq = (i >> 2) & 3;
  const int sw = (g ^ ((0x78 >> (2 * sq)) & 3)) * 16;
  int buf = 0, nbuf = 2;
  for (int kt = 0; kt < nk; ++kt) {
    if (kt + 1 < nk) asm volatile("s_waitcnt vmcnt(6)" ::: "memory");
    else asm volatile("s_waitcnt vmcnt(0)" ::: "memory");
    __builtin_amdgcn_s_barrier();
    asm volatile("" ::: "memory");
    ldsp sa = smem + buf * GSTAGE, sb = sa + 8192;
    bf16x8 a[4], b0[4];
#pragma unroll
    for (int mf = 0; mf < 4; ++mf) a[mf] = ld128(sa + (wr * 64 + mf * 16 + i) * 64 + sw);
#pragma unroll
    for (int nf = 0; nf < 4; ++nf) b0[nf] = ld128(sb + (wc * 128 + nf * 16 + i) * 64 + sw);
    if (kt + 2 < nk) stage(kt + 2, nbuf);
    bf16x8 b[4];
#pragma unroll
    for (int nf = 0; nf < 3; ++nf) b[nf] = ld128(sb + (wc * 128 + (4 + nf) * 16 + i) * 64 + sw);
    __builtin_amdgcn_s_setprio(1);
#pragma unroll
    for (int nf = 0; nf < 4; ++nf)
#pragma unroll
      for (int mf = 0; mf < 4; ++mf) acc[nf][mf] = mfma16(b0[nf], a[mf], acc[nf][mf]);
    __builtin_amdgcn_s_setprio(0);
    {
#pragma unroll
      for (int nf = 3; nf < 4; ++nf) b[nf] = ld128(sb + (wc * 128 + (4 + nf) * 16 + i) * 64 + sw);
      __builtin_amdgcn_s_setprio(1);
#pragma unroll
      for (int nf = 0; nf < 4; ++nf)
#pragma unroll
        for (int mf = 0; mf < 4; ++mf) acc[4 + nf][mf] = mfma16(b[nf], a[mf], acc[4 + nf][mf]);
      __builtin_amdgcn_s_setprio(0);
    }
    buf = buf == 2 ? 0 : buf + 1;
    nbuf = nbuf == 2 ? 0 : nbuf + 1;
  }
  __syncthreads();
}
__device__ __forceinline__ void tile_map(int t, int NT, int& mt, int& nt) {
  int xcd = t & 7, local = t >> 3;
  nt = local % NT;
  mt = (local / NT) * 8 + xcd;
}

__device__ __forceinline__ void ph_inproj(const P& p, int layer, ldsp smem) {
  const int tid = tidx(), lane = tid & 63, wid = tid >> 6, wr = wid >> 1, wc = wid & 1, i = lane & 15, g = lane >> 4;
  const bf16_t* Bt = p.WinT + (long)layer * NP * DM;
  const int co = gemm_chunk_off();
  for (int tile = blockIdx.x; tile < 256 * 12; tile += gridDim.x) {
    int mt, nt;
    tile_map(tile, 12, mt, nt);
    int m0 = mt * 128, n0 = nt * 256;
    unsigned voffA[2], voffB[4];
#pragma unroll
    for (int q = 0; q < 2; ++q) voffA[q] = (unsigned)(((tid >> 2) + 64 * q) * 32 + co) * 2u;
#pragma unroll
    for (int q = 0; q < 4; ++q) voffB[q] = (unsigned)(((tid >> 2) + 64 * q) * 32 + co) * 2u;
    f32x4 acc[8][4];
    gemm_core<false>(acc, (const char*)(p.h + (long)m0 * 32), voffA, (size_t)NTOK * 64, (const char*)(Bt + (long)n0 * 32), voffB, (size_t)NP * 64, DM / 32, smem);
#pragma unroll
    for (int mf = 0; mf < 4; ++mf) {
      const float rs = row_rstd(p.ssqp, m0 + wr * 64 + mf * 16 + i);
#pragma unroll
      for (int nf = 0; nf < 8; ++nf) acc[nf][mf] *= rs;
    }
#pragma unroll
    for (int hh = 0; hh < 2; ++hh) {
      int unit = (n0 + wc * 128 + hh * 64) >> 6;
      bool dorope = (unit >= 36 && unit <= 40) || unit == 42 || unit == 44;
      float qs = (unit >= 36 && unit <= 39) ? 0.125f * 1.4426950408889634f : 1.0f;
#pragma unroll
      for (int mf = 0; mf < 4; ++mf) {
        int row = m0 + wr * 64 + mf * 16 + i;
        if (dorope) {
          int t = row & (SEQ - 1);
#pragma unroll
          for (int n = 0; n < 2; ++n) {
            float4 c4 = *(const float4*)(p.rope + t * 64 + n * 16 + 4 * g);
            float4 s4 = *(const float4*)(p.rope + t * 64 + 32 + n * 16 + 4 * g);
            const float cc[4] = {c4.x, c4.y, c4.z, c4.w}, ss[4] = {s4.x, s4.y, s4.z, s4.w};
#pragma unroll
            for (int r = 0; r < 4; ++r) {
              float x1 = acc[hh * 4 + n][mf][r], x2 = acc[hh * 4 + n + 2][mf][r];
              acc[hh * 4 + n][mf][r] = (x1 * cc[r] - x2 * ss[r]) * qs;
              acc[hh * 4 + n + 2][mf][r] = (x2 * cc[r] + x1 * ss[r]) * qs;
            }
          }
        }
#pragma unroll
        for (int n = 0; n < 4; ++n) {
          f32x4 v = acc[hh * 4 + n][mf];
          u32x2 o; o.x = pk2(v[0], v[1]); o.y = pk2(v[2], v[3]);
          *(u32x2*)(p.proj + (long)row * NP + n0 + wc * 128 + (hh * 4 + n) * 16 + 4 * g) = o;
        }
      }
    }
  }
}

__device__ __forceinline__ void ph_resgemm(const bf16_t* A, int K, const bf16_t* Bt, bf16_t* hout, float* ssqp, ldsp smem) {
  const int tid = tidx(), lane = tid & 63, wid = tid >> 6, wr = wid >> 1, wc = wid & 1, i = lane & 15, g = lane >> 4;
  const int co = gemm_chunk_off();
  for (int tile = blockIdx.x; tile < 256 * 4; tile += gridDim.x) {
    int mt, nt;
    tile_map(tile, 4, mt, nt);
    int m0 = mt * 128, n0 = nt * 256;
    unsigned voffA[2], voffB[4];
#pragma unroll
    for (int q = 0; q < 2; ++q) voffA[q] = (unsigned)(((tid >> 2) + 64 * q) * 32 + co) * 2u;
#pragma unroll
    for (int q = 0; q < 4; ++q) voffB[q] = (unsigned)(((tid >> 2) + 64 * q) * 32 + co) * 2u;
    f32x4 acc[8][4];
    gemm_core<false>(acc, (const char*)(A + (long)m0 * 32), voffA, (size_t)NTOK * 64, (const char*)(Bt + (long)n0 * 32), voffB, (size_t)DM * 64, K / 32, smem);
#pragma unroll
    for (int mf = 0; mf < 4; ++mf) {
      long row = m0 + wr * 64 + mf * 16 + i;
      u32x2 xi[8];
#pragma unroll
      for (int nf = 0; nf < 8; ++nf) xi[nf] = *(const u32x2*)(hout + slab_idx(row, n0 + wc * 128 + nf * 16 + 4 * g, NTOK));
      float ss = 0.f;
#pragma unroll
      for (int nf = 0; nf < 8; ++nf) {
        f32x4 v = acc[nf][mf];
        float4 o; o.x = bflo(xi[nf].x) + v[0]; o.y = bfhi(xi[nf].x) + v[1]; o.z = bflo(xi[nf].y) + v[2]; o.w = bfhi(xi[nf].y) + v[3];
        ss += o.x * o.x + o.y * o.y + o.z * o.z + o.w * o.w;
        u32x2 hb; hb.x = pk2(o.x, o.y); hb.y = pk2(o.z, o.w);
        *(u32x2*)(hout + slab_idx(row, n0 + wc * 128 + nf * 16 + 4 * g, NTOK)) = hb;
      }
      ss += __shfl_xor(ss, 16);
      ss += __shfl_xor(ss, 32);
      if (g == 0) ssqp[row * 8 + nt * 2 + wc] = ss;
      asm volatile("" ::: "memory");
    }
  }
}

__device__ __forceinline__ void cmp_gemm1_tile(const P& p, int layer, int item, ldsp smem) {
  asm volatile("" : "+s"(layer));
  const int tid = tidx(), lane = tid & 63, wid = tid >> 6, wr = wid >> 1, wc = wid & 1, i = lane & 15, g = lane >> 4;
  const int co = gemm_chunk_off();
  int kv = item >> 4, mt = item & 15;
  int m0 = mt * 128;
  const bf16_t* A = p.proj + (kv ? C_VC : C_KC);
  const bf16_t* Bt = p.W1T + (long)(layer * 2 + kv) * 128 * 2048;
  unsigned voffA[2], voffB[4];
#pragma unroll
  for (int q = 0; q < 2; ++q) voffA[q] = (unsigned)(((tid >> 2) + 64 * q) * 16 * NP + co) * 2u;
#pragma unroll
  for (int q = 0; q < 4; ++q) voffB[q] = (unsigned)(((tid >> 2) + 64 * (q & 1)) * 32 + co) * 2u;
  f32x4 acc[8][4];
  gemm_core<true>(acc, (const char*)(A + (long)m0 * 16 * NP), voffA, 0, (const char*)Bt, voffB, (size_t)128 * 64, 64, smem);
  const float* c1 = p.c1 + (layer * 2 + kv) * 128;
  bf16_t* hid = p.hid + (long)kv * 2048 * 128;
  if (wc == 0) {
#pragma unroll
    for (int mf = 0; mf < 4; ++mf) {
      int row = m0 + wr * 64 + mf * 16 + i;
#pragma unroll
      for (int nf = 0; nf < 8; ++nf) {
        int col = nf * 16 + 4 * g;
        float4 cb = *(const float4*)(c1 + col);
        f32x4 v = acc[nf][mf];
        u32x2 o;
        o.x = pk2(geluf(v[0] + cb.x), geluf(v[1] + cb.y));
        o.y = pk2(geluf(v[2] + cb.z), geluf(v[3] + cb.w));
        *(u32x2*)(hid + (long)row * 128 + col) = o;
      }
    }
  }
}

__device__ __forceinline__ void ph_ffn_up(const P& p, int layer, ldsp smem) {
  const int tid = tidx(), lane = tid & 63, wid = tid >> 6, wr = wid >> 1, wc = wid & 1, i = lane & 15, g = lane >> 4;
  const int co = gemm_chunk_off();
  const bf16_t* Bt = p.WupT + (long)layer * 5632 * DM;
  const float* cw = p.ffn_conv_w + (long)layer * 3 * 2 * DFF;
  const float* cb = p.ffn_conv_b + (long)layer * 2 * DFF;
  constexpr int MT = 264, NT = 22;
  for (int tile = blockIdx.x; tile < MT * NT; tile += gridDim.x) {
    int mtb, nt;
    tile_map(tile, NT, mtb, nt);
    int b = mtb / 66, mj = mtb % 66;
    int tokbase = 126 * mj - 2;
    unsigned voffA[2], voffB[4];
#pragma unroll
    for (int q = 0; q < 2; ++q) {
      int tk = tokbase + (tid >> 2) + 64 * q;
      tk = tk < 0 ? 0 : (tk >= SEQ ? SEQ - 1 : tk);
      voffA[q] = (unsigned)(tk * 32 + co) * 2u;
    }
#pragma unroll
    for (int q = 0; q < 4; ++q) voffB[q] = (unsigned)(((tid >> 2) + 64 * q) * 32 + co) * 2u;
    f32x4 acc[8][4];
    gemm_core<false>(acc, (const char*)(p.h + (long)b * SEQ * 32), voffA, (size_t)NTOK * 64, (const char*)(Bt + (long)nt * 256 * 32), voffB, (size_t)5632 * 64, DM / 32, smem);
#pragma unroll
    for (int mf = 0; mf < 4; ++mf) {
      const int tkr = tokbase + wr * 64 + mf * 16 + i;
      const float rs = (tkr >= 0 && tkr < SEQ) ? row_rstd(p.ssqp, (long)b * SEQ + tkr) : 0.f;
#pragma unroll
      for (int nf = 0; nf < 8; ++nf) {
        int r = wr * 64 + mf * 16 + i, c = wc * 128 + nf * 16 + 4 * g;
        f32x4 v = acc[nf][mf] * rs;
        u32x2 o; o.x = pk2(v[0], v[1]); o.y = pk2(v[2], v[3]);
        *(LAS u32x2*)(smem + r * 528 + c * 2) = o;
      }
    }
    __syncthreads();
    {
      const int ac = (tid & 15) * 8;
      const int pi = ac >> 6, pc = ac & 63;
      const int pair = 2 * nt + pi;
      if (pair < 43) {
        const int gcol = pair * 64 + pc;
        const int lg = (pi * 128 + pc) * 2, lv = (pi * 128 + 64 + pc) * 2;
        h16x2 wg[3][4], wv[3][4], bg[4], bv[4];
#pragma unroll
        for (int q = 0; q < 4; ++q) {
#pragma unroll
          for (int j = 0; j < 3; ++j) {
            const float2 a2 = *(const float2*)(cw + j * 2 * DFF + gcol + 2 * q), b2 = *(const float2*)(cw + j * 2 * DFF + DFF + gcol + 2 * q);
            wg[j][q].x = (_Float16)a2.x; wg[j][q].y = (_Float16)a2.y;
            wv[j][q].x = (_Float16)b2.x; wv[j][q].y = (_Float16)b2.y;
          }
          const float2 c2 = *(const float2*)(cb + gcol + 2 * q), d2 = *(const float2*)(cb + DFF + gcol + 2 * q);
          bg[q].x = (_Float16)c2.x; bg[q].y = (_Float16)c2.y;
          bv[q].x = (_Float16)d2.x; bv[q].y = (_Float16)d2.y;
        }
#pragma unroll 2
        for (int it = 0; it < 8; ++it) {
          int r = 2 + (tid >> 4) + 16 * it;
          int tk = tokbase + r;
          if (r < 128 && tk < SEQ) {
            h16x2 ga[4], va[4];
#pragma unroll
            for (int q = 0; q < 4; ++q) { ga[q] = bg[q]; va[q] = bv[q]; }
#pragma unroll
            for (int j = 0; j < 3; ++j) {
              const u32x4 tg = *(LAS const u32x4*)(smem + (r - 2 + j) * 528 + lg);
              const u32x4 tv = *(LAS const u32x4*)(smem + (r - 2 + j) * 528 + lv);
              const unsigned tgs[4] = {tg.x, tg.y, tg.z, tg.w}, tvs[4] = {tv.x, tv.y, tv.z, tv.w};
#pragma unroll
              for (int q = 0; q < 4; ++q) {
                ga[q] = wg[j][q] * __builtin_bit_cast(h16x2, tgs[q]) + ga[q];
                va[q] = wv[j][q] * __builtin_bit_cast(h16x2, tvs[q]) + va[q];
              }
            }
            u32x4 ov;
            unsigned ow[4];
#pragma unroll
            for (int q = 0; q < 4; ++q) ow[q] = pk2(siluf((float)ga[q].x) * (float)va[q].x, siluf((float)ga[q].y) * (float)va[q].y);
            ov.x = ow[0]; ov.y = ow[1]; ov.z = ow[2]; ov.w = ow[3];
            *(u32x4*)(p.act + slab_idx((long)b * SEQ + tk, gcol, NTOK)) = ov;
          }
        }
      }
    }
  }
}

__device__ __forceinline__ void xbc_conv8(const P& p, int layer, long row, int tb, int ccol, float* o) {
  const bf16_t* wh = p.cwh + (long)layer * 5120 + ccol;
  const u32x4 bb = gld128(wh + 4096);
  h16x2 acc0 = as_h2(bb.x), acc1 = as_h2(bb.y), acc2 = as_h2(bb.z), acc3 = as_h2(bb.w);
#pragma unroll
  for (int j = 0; j < 4; ++j) {
    if (tb - 3 + j >= 0) {
      const u32x4 v = gld128(p.proj + (row - 3 + j) * NP + C_XBC + ccol);
      const u32x4 w = gld128(wh + j * 1024);
      acc0 = as_h2(w.x) * as_h2(v.x) + acc0;
      acc1 = as_h2(w.y) * as_h2(v.y) + acc1;
      acc2 = as_h2(w.z) * as_h2(v.z) + acc2;
      acc3 = as_h2(w.w) * as_h2(v.w) + acc3;
    }
  }
  o[0] = siluf((float)acc0.x); o[1] = siluf((float)acc0.y); o[2] = siluf((float)acc1.x); o[3] = siluf((float)acc1.y);
  o[4] = siluf((float)acc2.x); o[5] = siluf((float)acc2.y); o[6] = siluf((float)acc3.x); o[7] = siluf((float)acc3.y);
}

__device__ __forceinline__ void ssd_dt_scan(const P& p, int layer, long row0, int hd, int lane, ldsp dts, ldsp acs) {
  float dtr = bf2f(p.proj[(row0 + lane) * NP + C_DT + hd]) + p.ssd_dt_bias[layer * 8 + hd];
  float dt = softplusf(dtr);
  float a = -dt * expf(p.ssd_a_log[layer * 8 + hd]);
  float cs = a;
#pragma unroll
  for (int o = 1; o < 64; o <<= 1) {
    float t = __shfl_up(cs, o);
    if (lane >= o) cs += t;
  }
  stsf(dts + lane * 4, dt);
  stsf(acs + lane * 4, cs);
}

__device__ __forceinline__ void ssd1_item(const P& p, int layer, int item, ldsp smem) {
  asm volatile("" : "+s"(layer));
  const int tid = tidx(), lane = tid & 63, w = tid >> 6, i = lane & 15, g = lane >> 4;
  int b = item >> 8, c = (item >> 1) & 127, grp = item & 1;
  long row0 = (long)b * SEQ + c * 64;
  int tb0 = c * 64;
  ldsp Bs = smem, Xs = smem + 17408, dts = smem + 51200, acs = smem + 52224;
  __syncthreads();
  ssd_dt_scan(p, layer, row0, 4 * grp + w, lane, dts + w * 256, acs + w * 256);
  __syncthreads();
#pragma unroll 1
  for (int it = 0; it < 4; ++it) {
    int r = (tid >> 4) + 16 * it, ch = tid & 15;
    float o[8];
    xbc_conv8(p, layer, row0 + r, tb0 + r, 512 + 128 * grp + ch * 8, o);
    st128(Bs + r * 272 + ch * 16, __builtin_bit_cast(u32x4, pack8(o)));
  }
#pragma unroll 2
  for (int it = 0; it < 8; ++it) {
    int r = (tid >> 5) + 8 * it, ch = tid & 31;
    int hh = ch >> 3;
    float o[8];
    xbc_conv8(p, layer, row0 + r, tb0 + r, (4 * grp) * 64 + ch * 8, o);
    float sc = ldsf(dts + hh * 256 + r * 4) * __expf(ldsf(acs + hh * 256 + 63 * 4) - ldsf(acs + hh * 256 + r * 4));
#pragma unroll
    for (int e = 0; e < 8; ++e) o[e] *= sc;
    st128(Xs + r * 528 + ch * 16, __builtin_bit_cast(u32x4, pack8(o)));
  }
  __syncthreads();
  int hd = 4 * grp + w;
  bf16_t* st = p.states + (((long)b * 128 + c) * 8 + hd) * 8192;
#pragma unroll 1
  for (int nh = 0; nh < 2; ++nh) {
    f32x4 acc[4][4];
#pragma unroll
    for (int pf = 0; pf < 4; ++pf)
#pragma unroll
      for (int nf = 0; nf < 4; ++nf) acc[pf][nf] = (f32x4){0.f, 0.f, 0.f, 0.f};
#pragma unroll
    for (int ks = 0; ks < 2; ++ks) {
      bf16x8 af[4], bfr[4];
      int rr = 32 * ks + 8 * g + (i >> 2);
#pragma unroll
      for (int pf = 0; pf < 4; ++pf) {
        ldsp a = Xs + rr * 528 + (64 * w + 16 * pf + 4 * (i & 3)) * 2;
        af[pf] = cat4(ldtr(a), ldtr(a + 4 * 528));
      }
#pragma unroll
      for (int nf = 0; nf < 4; ++nf) {
        ldsp a = Bs + rr * 272 + (16 * (4 * nh + nf) + 4 * (i & 3)) * 2;
        bfr[nf] = cat4(ldtr(a), ldtr(a + 4 * 272));
      }
#pragma unroll
      for (int pf = 0; pf < 4; ++pf)
#pragma unroll
        for (int nf = 0; nf < 4; ++nf) acc[pf][nf] = mfma16(bfr[nf], af[pf], acc[pf][nf]);
    }
#pragma unroll
    for (int pf = 0; pf < 4; ++pf)
#pragma unroll
      for (int nf = 0; nf < 4; ++nf)
      {
        const f32x4 v = acc[pf][nf];
        u32x2 o; o.x = pk2(v[0], v[1]); o.y = pk2(v[2], v[3]);
        *(u32x2*)(st + (16 * pf + i) * 128 + 16 * (4 * nh + nf) + 4 * g) = o;
      }
  }
  if (lane == 0) p.cdec[((long)b * 128 + c) * 8 + hd] = __expf(ldsf(acs + w * 256 + 63 * 4));
}

__device__ __forceinline__ void ssd2_item(const P& p, int item) {
  asm volatile("" : "+s"(item));
  int idx = item * 256 + tidx();
  int bh = idx >> 12, e = idx & 4095;
  int b = bh >> 3, hd = bh & 7;
  unsigned* S = (unsigned*)p.states;
  float h0 = 0.f, h1 = 0.f;
  for (int c0 = 0; c0 < 128; c0 += 16) {
    unsigned v[16]; float dc[16];
#pragma unroll
    for (int u = 0; u < 16; ++u) {
      long cb = ((long)b * 128 + c0 + u) * 8 + hd;
      v[u] = S[cb * 4096 + e];
      dc[u] = p.cdec[cb];
    }
#pragma unroll
    for (int u = 0; u < 16; ++u) {
      long cb = ((long)b * 128 + c0 + u) * 8 + hd;
      S[cb * 4096 + e] = pk2(h0, h1);
      h0 = h0 * dc[u] + bflo(v[u]);
      h1 = h1 * dc[u] + bfhi(v[u]);
    }
  }
}

__device__ __forceinline__ void cmp_gemm2_item(const P& p, int layer, int item) {
  asm volatile("" : "+s"(layer));
  int idx = item * 256 + tidx();
  int kv = idx >> 17, m = (idx >> 6) & 2047, d = idx & 63;
  const float* w2 = (kv ? p.cmp_v_w2 : p.cmp_k_w2) + (long)layer * 128 * 64;
  const bf16_t* hr = p.hid + ((long)kv * 2048 + m) * 128;
  float s = 0.f;
  if ((m & 511) != 511) {
    for (int n8 = 0; n8 < 16; ++n8) {
      float v[8];
      unpack8(gld128(hr + n8 * 8), v);
#pragma unroll
      for (int e = 0; e < 8; ++e) s += v[e] * w2[(n8 * 8 + e) * 64 + d];
    }
  }
  p.kcvc[((long)kv * 2048 + m) * 64 + d] = f2bf(s);
}

__device__ __forceinline__ void shortconv_item(const P& p, int layer, int item) {
  asm volatile("" : "+s"(layer));
  const int tid = tidx();
  const float* cw = p.sc_conv_w + (long)layer * 3 * 256;
  for (int it = 0; it < 8; ++it) {
    int q = it * 256 + tid;
    int r = q >> 5, ch = q & 31;
    long row = (long)item * 64 + r;
    int tb = (int)(row & (SEQ - 1));
    float o[8];
#pragma unroll
    for (int e = 0; e < 8; ++e) o[e] = 0.f;
#pragma unroll
    for (int j = 0; j < 3; ++j) {
      if (tb - 2 + j >= 0) {
        float a[8], bb[8];
        unpack8(gld128(p.proj + (row - 2 + j) * NP + C_SCC + ch * 8), a);
        unpack8(gld128(p.proj + (row - 2 + j) * NP + C_SCH + ch * 8), bb);
#pragma unroll
        for (int e = 0; e < 8; ++e) o[e] += cw[j * 256 + ch * 8 + e] * (a[e] * bb[e]);
      }
    }
    float sb[8];
    unpack8(gld128(p.proj + row * NP + C_SCB + ch * 8), sb);
#pragma unroll
    for (int e = 0; e < 8; ++e) o[e] *= sb[e];
    *(u32x4*)(p.ymix + slab_idx(row, 512 + ch * 8, NTOK)) = __builtin_bit_cast(u32x4, pack8(o));
  }
}

__device__ __forceinline__ void ssd3_item(const P& p, int layer, int item, ldsp smem) {
  asm volatile("" : "+s"(layer));
  const int tid = tidx(), lane = tid & 63, w = tid >> 6, i = lane & 15, g = lane >> 4;
  int b = item >> 7, c = item & 127;
  long row0 = (long)b * SEQ + c * 64;
  int tb0 = c * 64;
  ldsp Cs = smem, Bs = smem + 17408, Xh = smem + 34816, dts = smem + 44032, acs = smem + 45056;
  float ssq = 0.f;
  const int lq = 16 * w + i;
#pragma unroll 1
  for (int grp = 0; grp < 2; ++grp) {
    __syncthreads();
    ssd_dt_scan(p, layer, row0, 4 * grp + w, lane, dts + w * 256, acs + w * 256);
    for (int it = 0; it < 4; ++it) {
      int r = (tid >> 4) + 16 * it, ch = tid & 15;
      float o[8];
      xbc_conv8(p, layer, row0 + r, tb0 + r, 768 + 128 * grp + ch * 8, o);
      st128(Cs + r * 272 + ch * 16, __builtin_bit_cast(u32x4, pack8(o)));
      xbc_conv8(p, layer, row0 + r, tb0 + r, 512 + 128 * grp + ch * 8, o);
      st128(Bs + r * 272 + ch * 16, __builtin_bit_cast(u32x4, pack8(o)));
    }
    __syncthreads();
    bf16x8 cf[4];
#pragma unroll
    for (int ks = 0; ks < 4; ++ks) cf[ks] = ld128(Cs + lq * 272 + (32 * ks + 8 * g) * 2);
    f32x4 sT[4];
#pragma unroll
    for (int sf = 0; sf < 4; ++sf) {
      sT[sf] = (f32x4){0.f, 0.f, 0.f, 0.f};
#pragma unroll
      for (int ks = 0; ks < 4; ++ks) sT[sf] = mfma16(ld128(Bs + (16 * sf + i) * 272 + (32 * ks + 8 * g) * 2), cf[ks], sT[sf]);
    }
#pragma unroll 1
    for (int hh = 0; hh < 4; ++hh) {
      const int hd = 4 * grp + hh;
      __syncthreads();
      {
        const bf16_t* st = p.states + (((long)b * 128 + c) * 8 + hd) * 8192;
        for (int it = 0; it < 4; ++it) {
          int r = (tid >> 4) + 16 * it, ch = tid & 15;
          st128(Bs + r * 272 + ch * 16, gld128(st + r * 128 + ch * 8));
        }
        for (int it = 0; it < 2; ++it) {
          int r = (tid >> 3) + 32 * it, ch = tid & 7;
          float o[8];
          xbc_conv8(p, layer, row0 + r, tb0 + r, hd * 64 + ch * 8, o);
          st128(Xh + r * 144 + ch * 16, __builtin_bit_cast(u32x4, pack8(o)));
        }
      }
      __syncthreads();
      f32x4 acc[4];
#pragma unroll
      for (int pf = 0; pf < 4; ++pf) {
        acc[pf] = (f32x4){0.f, 0.f, 0.f, 0.f};
#pragma unroll
        for (int ks = 0; ks < 4; ++ks) acc[pf] = mfma16(ld128(Bs + (16 * pf + i) * 272 + (32 * ks + 8 * g) * 2), cf[ks], acc[pf]);
      }
      const float al = ldsf(acs + hh * 256 + lq * 4);
      const float el = __expf(al);
#pragma unroll
      for (int pf = 0; pf < 4; ++pf) acc[pf] *= el;
      const float Dh = p.ssd_d[layer * 8 + hd];
      f32x4 pt[4];
#pragma unroll
      for (int sf = 0; sf < 4; ++sf)
#pragma unroll
        for (int r = 0; r < 4; ++r) {
          int s = 16 * sf + 4 * g + r;
          float v = 0.f;
          if (s <= lq) v = sT[sf][r] * ldsf(dts + hh * 256 + s * 4) * __expf(al - ldsf(acs + hh * 256 + s * 4));
          if (s == lq) v += Dh;
          pt[sf][r] = v;
        }
#pragma unroll
      for (int ks = 0; ks < 2; ++ks) {
        bf16x8 pb = pack44(pt[2 * ks], pt[2 * ks + 1]);
#pragma unroll
        for (int pf = 0; pf < 4; ++pf) {
          ldsp a = Xh + (32 * ks + 4 * g + (i >> 2)) * 144 + (16 * pf + 4 * (i & 3)) * 2;
          acc[pf] = mfma16(cat4(ldtr(a), ldtr(a + 16 * 144)), pb, acc[pf]);
        }
      }
#pragma unroll
      for (int pf = 0; pf < 4; ++pf) {
        int col = hd * 64 + 16 * pf + 4 * g;
        u32x2 zz = *(const u32x2*)(p.proj + (row0 + lq) * NP + C_Z + col);
        float z0 = bflo(zz.x), z1 = bfhi(zz.x), z2 = bflo(zz.y), z3 = bfhi(zz.y);
        f32x4 y;
        y[0] = acc[pf][0] * siluf(z0); y[1] = acc[pf][1] * siluf(z1);
        y[2] = acc[pf][2] * siluf(z2); y[3] = acc[pf][3] * siluf(z3);
        ssq += y[0] * y[0] + y[1] * y[1] + y[2] * y[2] + y[3] * y[3];
        { u32x2 yp; yp.x = pk2(y[0], y[1]); yp.y = pk2(y[2], y[3]); *(u32x2*)(p.ymix + slab_idx(row0 + lq, col, NTOK)) = yp; }
      }
    }
  }
  ssq += __shfl_xor(ssq, 16);
  ssq += __shfl_xor(ssq, 32);
  const float rstd = rsqrtf(ssq * (1.f / 512.f) + 1e-6f);
  const float* nw = p.ssd_norm_w + layer * 512;
#pragma unroll 1
  for (int q = 0; q < 32; ++q) {
    int col = (q >> 2) * 64 + 16 * (q & 3) + 4 * g;
    float4 w4 = *(const float4*)(nw + col);
    u32x2* yp_ = (u32x2*)(p.ymix + slab_idx(row0 + lq, col, NTOK));
    u32x2 yp = *yp_;
    u32x2 o;
    o.x = pk2(bflo(yp.x) * rstd * w4.x, bfhi(yp.x) * rstd * w4.y);
    o.y = pk2(bflo(yp.y) * rstd * w4.z, bfhi(yp.y) * rstd * w4.w);
    *yp_ = o;
  }
}

template <int NH>
__device__ __forceinline__ void qk_tile(f32x4 (&s)[4][NH], ldsp Ks, const bf16x8 (&qf)[NH][2], int i, int g) {
#pragma unroll
  for (int kf = 0; kf < 4; ++kf)
#pragma unroll
    for (int h = 0; h < NH; ++h) s[kf][h] = (f32x4){0.f, 0.f, 0.f, 0.f};
  __builtin_amdgcn_s_setprio(1);
#pragma unroll
  for (int ks = 0; ks < 2; ++ks)
#pragma unroll
    for (int kf = 0; kf < 4; ++kf) {
      bf16x8 a = ld128(Ks + (16 * kf + i) * 144 + (32 * ks + 8 * g) * 2);
#pragma unroll
      for (int h = 0; h < NH; ++h) s[kf][h] = mfma16(a, qf[h][ks], s[kf][h]);
    }
  __builtin_amdgcn_s_setprio(0);
}
__device__ __forceinline__ void pv_tile(f32x4 (&o)[4][2], ldsp Vs, const f32x4 (&s)[4][2], int i, int g) {
  __builtin_amdgcn_s_setprio(1);
#pragma unroll
  for (int ks = 0; ks < 2; ++ks) {
    bf16x8 pb[2];
#pragma unroll
    for (int h = 0; h < 2; ++h) pb[h] = pack44_rtz(s[2 * ks][h], s[2 * ks + 1][h]);
#pragma unroll
    for (int df = 0; df < 4; ++df) {
      ldsp a = Vs + (32 * ks + 4 * g + (i >> 2)) * 144 + (16 * df + 4 * (i & 3)) * 2;
      bf16x8 av = cat4(ldtr(a), ldtr(a + 16 * 144));
#pragma unroll
      for (int h = 0; h < 2; ++h) o[df][h] = mfma16(av, pb[h], o[df][h]);
    }
  }
  __builtin_amdgcn_s_setprio(0);
}
__device__ __forceinline__ void stage64_ld(u32x4 (&r)[2], const bf16_t* src, long stride) {
  const int tid = tidx();
#pragma unroll
  for (int it = 0; it < 2; ++it) r[it] = gld128(src + (long)((tid >> 3) + 32 * it) * stride + (tid & 7) * 8);
}
__device__ __forceinline__ void stage64_st(const u32x4 (&r)[2], ldsp dst) {
  const int tid = tidx();
#pragma unroll
  for (int it = 0; it < 2; ++it) st128(dst + ((tid >> 3) + 32 * it) * 144 + (tid & 7) * 16, r[it]);
}

__device__ __forceinline__ void osm_update(f32x4 (&s)[4][2], const bool (&vm)[4][4], float (&m)[2], float (&l)[2], f32x4 (&o)[4][2]) {
#pragma unroll
  for (int h = 0; h < 2; ++h) {
    float tmax = -1e30f;
#pragma unroll
    for (int kf = 0; kf < 4; ++kf)
#pragma unroll
      for (int r = 0; r < 4; ++r) {
        float v = vm[kf][r] ? s[kf][h][r] : -1e30f;
        tmax = fmaxf(tmax, v);
      }
    tmax = fmaxf(tmax, __shfl_xor(tmax, 16));
    tmax = fmaxf(tmax, __shfl_xor(tmax, 32));
    float mnew = fmaxf(m[h], tmax);
    float alpha = ex2(m[h] - mnew);
    m[h] = mnew;
    float ps = 0.f;
#pragma unroll
    for (int kf = 0; kf < 4; ++kf)
#pragma unroll
      for (int r = 0; r < 4; ++r) {
        float pv = vm[kf][r] ? ex2(s[kf][h][r] - mnew) : 0.f;
        s[kf][h][r] = pv;
        ps += pv;
      }
    l[h] = l[h] * alpha + ps;
#pragma unroll
    for (int df = 0; df < 4; ++df) o[df][h] *= alpha;
  }
}

template <bool LANEMASK>
__device__ __forceinline__ void osm_update_full(f32x4 (&s)[4][2], bool lv, float (&m)[2], float (&l)[2], f32x4 (&o)[4][2]) {
#pragma unroll
  for (int h = 0; h < 2; ++h) {
    float tmax = s[0][h][0];
#pragma unroll
    for (int kf = 0; kf < 4; ++kf)
#pragma unroll
      for (int r = 0; r < 4; ++r) tmax = fmaxf(tmax, s[kf][h][r]);
    if (LANEMASK) tmax = lv ? tmax : -1e30f;
    tmax = fmaxf(tmax, __shfl_xor(tmax, 16));
    tmax = fmaxf(tmax, __shfl_xor(tmax, 32));
    float mnew = fmaxf(m[h], tmax);
    float alpha = ex2(m[h] - mnew);
    m[h] = mnew;
    float ps = 0.f;
#pragma unroll
    for (int kf = 0; kf < 4; ++kf)
#pragma unroll
      for (int r = 0; r < 4; ++r) {
        float pv = ex2(s[kf][h][r] - mnew);
        if (LANEMASK) pv = lv ? pv : 0.f;
        s[kf][h][r] = pv;
        ps += pv;
      }
    l[h] = l[h] * alpha + ps;
#pragma unroll
    for (int df = 0; df < 4; ++df) o[df][h] *= alpha;
  }
}

__device__ __forceinline__ void nsa_item(const P& p, int layer, int item, ldsp smem) {
  asm volatile("" : "+s"(layer));
  const int tid = tidx(), lane = tid & 63, w = tid >> 6, i = lane & 15, g = lane >> 4;
  const int sub = item & 7, b = sub >> 1, hp = sub & 1;
  const int rnk = (item & 511) >> 3;
  const int qt = item < 512 ? 127 - rnk : rnk;
  const int t0 = qt * 64;
  const int tl = t0 + 16 * w + i;
  const long rowl = (long)b * SEQ + tl;
  const long rowb = (long)b * SEQ;
  ldsp Ks = smem, Vs = smem + 9216, imp = smem + 18432, selm = smem + 52224, uni = smem + 53248, lst = smem + 53280;
  const bf16_t* kc = p.kcvc + (long)b * 512 * 64;
  const bf16_t* vc = p.kcvc + (long)2048 * 64 + (long)b * 512 * 64;
  __syncthreads();
  for (int e = tid; e < 64 * 132; e += 256) stsf(imp + e * 4, 0.f);
  const int nhi = (t0 + 32) >> 4;
  const int ncmp = (nhi > 510 ? 510 : nhi) / 64 + 1;
  float m4[4], inv4[4];
  {
    bf16x8 qf[4][2];
#pragma unroll
    for (int h = 0; h < 4; ++h)
#pragma unroll
      for (int ks = 0; ks < 2; ++ks)
        qf[h][ks] = __builtin_bit_cast(bf16x8, gld128(p.proj + rowl * NP + C_Q + h * 64 + 32 * ks + 8 * g));
    float l4[4];
#pragma unroll
    for (int h = 0; h < 4; ++h) { m4[h] = -1e30f; l4[h] = 0.f; }
    {
      u32x4 kr[2];
      stage64_ld(kr, kc, 64);
      for (int kt = 0; kt < ncmp; ++kt) {
        __syncthreads();
        stage64_st(kr, Ks);
        __syncthreads();
        if (kt + 1 < ncmp) stage64_ld(kr, kc + (long)(kt + 1) * 64 * 64, 64);
        f32x4 s[4][4];
        qk_tile<4>(s, Ks, qf, i, g);
        const bool cfull = ((kt * 64 + 63) * 16 + 31 <= t0) && (kt * 64 + 63 < 511);
        if (cfull) {
#pragma unroll
          for (int h = 0; h < 4; ++h) {
            float tmax = s[0][h][0];
#pragma unroll
            for (int kf = 0; kf < 4; ++kf)
#pragma unroll
              for (int r = 0; r < 4; ++r) tmax = fmaxf(tmax, s[kf][h][r]);
            tmax = fmaxf(tmax, __shfl_xor(tmax, 16));
            tmax = fmaxf(tmax, __shfl_xor(tmax, 32));
            float mnew = fmaxf(m4[h], tmax);
            float ps = 0.f;
#pragma unroll
            for (int kf = 0; kf < 4; ++kf)
#pragma unroll
              for (int r = 0; r < 4; ++r) ps += ex2(s[kf][h][r] - mnew);
            l4[h] = l4[h] * ex2(m4[h] - mnew) + ps;
            m4[h] = mnew;
          }
        } else {
#pragma unroll
        for (int h = 0; h < 4; ++h) {
          float tmax = -1e30f;
#pragma unroll
          for (int kf = 0; kf < 4; ++kf)
#pragma unroll
            for (int r = 0; r < 4; ++r) {
              int key = kt * 64 + 16 * kf + 4 * g + r;
              bool ok = (key * 16 + 31 <= tl) && key < 511;
              float v = ok ? s[kf][h][r] : -1e30f;
              s[kf][h][r] = v;
              tmax = fmaxf(tmax, v);
            }
          tmax = fmaxf(tmax, __shfl_xor(tmax, 16));
          tmax = fmaxf(tmax, __shfl_xor(tmax, 32));
          float mnew = fmaxf(m4[h], tmax);
          float ps = 0.f;
#pragma unroll
          for (int kf = 0; kf < 4; ++kf)
#pragma unroll
            for (int r = 0; r < 4; ++r) ps += (s[kf][h][r] > -1e29f) ? ex2(s[kf][h][r] - mnew) : 0.f;
          l4[h] = l4[h] * ex2(m4[h] - mnew) + ps;
          m4[h] = mnew;
        }
        }
      }
    }
#pragma unroll
    for (int h = 0; h < 4; ++h) {
      float lt = l4[h];
      lt += __shfl_xor(lt, 16);
      lt += __shfl_xor(lt, 32);
      inv4[h] = 1.f / fmaxf(lt, 1e-20f);
    }
    {
      u32x4 kr[2];
      stage64_ld(kr, kc, 64);
      for (int kt = 0; kt < ncmp; ++kt) {
        __syncthreads();
        stage64_st(kr, Ks);
        __syncthreads();
        if (kt + 1 < ncmp) stage64_ld(kr, kc + (long)(kt + 1) * 64 * 64, 64);
        f32x4 s[4][4];
        qk_tile<4>(s, Ks, qf, i, g);
        const bool cfull2 = ((kt * 64 + 63) * 16 + 31 <= t0) && (kt * 64 + 63 < 511);
        float mainv[4], spill[4];
#pragma unroll
        for (int kf = 0; kf < 4; ++kf) {
          mainv[kf] = 0.f; spill[kf] = 0.f;
#pragma unroll
          for (int r = 0; r < 4; ++r) {
            float pr = 0.f;
            if (cfull2) {
#pragma unroll
              for (int h = 0; h < 4; ++h) pr += ex2(s[kf][h][r] - m4[h]) * inv4[h];
            } else {
              int key = kt * 64 + 16 * kf + 4 * g + r;
              bool ok = (key * 16 + 31 <= tl) && key < 511;
#pragma unroll
              for (int h = 0; h < 4; ++h) pr += ok ? ex2(s[kf][h][r] - m4[h]) * inv4[h] : 0.f;
            }
            mainv[kf] += pr;
            if (r == 3) spill[kf] = pr;
          }
        }
        ldsp ir = imp + (16 * w + i) * 528;
#pragma unroll
        for (int kf = 0; kf < 4; ++kf) {
          int blk = 16 * kt + 4 * kf + g;
          stsf(ir + blk * 4, ldsf(ir + blk * 4) + mainv[kf]);
        }
#pragma unroll
        for (int kf = 0; kf < 4; ++kf) {
          int blk = 16 * kt + 4 * kf + g + 1;
          stsf(ir + blk * 4, ldsf(ir + blk * 4) + spill[kf]);
        }
      }
    }
  }
  __syncthreads();
  {
    int tok = tid >> 2, sb = tid & 3;
    unsigned mask = 0;
    const int cur = qt;
    ldsp ir = imp + tok * 528;
    if (cur < 16) {
      for (int j = 32 * sb; j < 32 * sb + 32; ++j)
        if (j <= cur) mask |= 1u << (j & 31);
    } else {
      float v[32];
#pragma unroll
      for (int q4 = 0; q4 < 8; ++q4) {
        f32x4 vv = *(LAS const f32x4*)(ir + (32 * sb + 4 * q4) * 4);
#pragma unroll
        for (int e = 0; e < 4; ++e) {
          int j = 32 * sb + 4 * q4 + e;
          v[4 * q4 + e] = (j >= 1 && j <= cur - 2) ? vv[e] : -INFINITY;
          if (j == 0 || (j > cur - 2 && j <= cur)) mask |= 1u << (j & 31);
        }
      }
#pragma unroll 1
      for (int round = 0; round < 13; ++round) {
        float bv = -INFINITY; int be = 0;
#pragma unroll
        for (int e = 0; e < 32; ++e) { bool gt_ = v[e] > bv; bv = gt_ ? v[e] : bv; be = gt_ ? e : be; }
        int bj = 32 * sb + be;
#pragma unroll
        for (int o = 1; o <= 2; o <<= 1) {
          float ov = __shfl_xor(bv, o); int oj = __shfl_xor(bj, o);
          bool take = (ov > bv) || (ov == bv && oj < bj);
          bv = take ? ov : bv; bj = take ? oj : bj;
        }
        if ((bj >> 5) == sb) {
          int e0 = bj & 31;
          mask |= 1u << e0;
#pragma unroll
          for (int e = 0; e < 32; ++e) v[e] = (e == e0) ? -INFINITY : v[e];
        }
      }
    }
    stsu(selm + (tok * 4 + sb) * 4, mask);
  }
  __syncthreads();
  if (w == 0) {
    unsigned a0 = ldsu(selm + (lane * 4 + 0) * 4), a1 = ldsu(selm + (lane * 4 + 1) * 4), a2 = ldsu(selm + (lane * 4 + 2) * 4), a3 = ldsu(selm + (lane * 4 + 3) * 4);
#pragma unroll
    for (int o = 32; o >= 1; o >>= 1) { a0 |= __shfl_xor(a0, o); a1 |= __shfl_xor(a1, o); a2 |= __shfl_xor(a2, o); a3 |= __shfl_xor(a3, o); }
    if (lane == 0) { stsu(uni, a0); stsu(uni + 4, a1); stsu(uni + 8, a2); stsu(uni + 12, a3); }
  }
  __syncthreads();
  if (tid < 128) {
    const unsigned u0 = ldsu(uni), u1 = ldsu(uni + 4), u2 = ldsu(uni + 8), u3 = ldsu(uni + 12);
    const int wd = tid >> 5, bp = tid & 31;
    const unsigned uw = wd == 0 ? u0 : (wd == 1 ? u1 : (wd == 2 ? u2 : u3));
    const int pos = (wd > 0 ? __popc(u0) : 0) + (wd > 1 ? __popc(u1) : 0) + (wd > 2 ? __popc(u2) : 0) + __popc(uw & ((1u << bp) - 1u));
    if ((uw >> bp) & 1u) stsu(lst + 4 + pos * 4, (unsigned)tid);
    if (tid == 0) stsu(lst, (unsigned)(__popc(u0) + __popc(u1) + __popc(u2) + __popc(u3)));
  }
  __syncthreads();
  const int nsel = __builtin_amdgcn_readfirstlane((int)ldsu(lst));
  unsigned mysel[4];
#pragma unroll
  for (int q = 0; q < 4; ++q) mysel[q] = ldsu(selm + ((16 * w + i) * 4 + q) * 4);
  {
    bf16x8 qf[2][2];
    float gt[2][3];
#pragma unroll
    for (int h = 0; h < 2; ++h) {
#pragma unroll
      for (int ks = 0; ks < 2; ++ks)
        qf[h][ks] = __builtin_bit_cast(bf16x8, gld128(p.proj + rowl * NP + C_Q + (2 * hp + h) * 64 + 32 * ks + 8 * g));
#pragma unroll
      for (int br = 0; br < 3; ++br) gt[h][br] = sigmf(bf2f(p.proj[rowl * NP + C_G + 3 * (2 * hp + h) + br]));
    }
    float mh[2], ih[2];
    mh[0] = hp ? m4[2] : m4[0]; mh[1] = hp ? m4[3] : m4[1];
    ih[0] = hp ? inv4[2] : inv4[0]; ih[1] = hp ? inv4[3] : inv4[1];
    f32x4 out[4][2];
#pragma unroll
    for (int df = 0; df < 4; ++df)
#pragma unroll
      for (int h = 0; h < 2; ++h) out[df][h] = (f32x4){0.f, 0.f, 0.f, 0.f};
    {
      u32x4 kr[2], vr[2];
      stage64_ld(kr, kc, 64);
      stage64_ld(vr, vc, 64);
      for (int kt = 0; kt < ncmp; ++kt) {
        __syncthreads();
        stage64_st(kr, Ks);
        stage64_st(vr, Vs);
        __syncthreads();
        if (kt + 1 < ncmp) {
          stage64_ld(kr, kc + (long)(kt + 1) * 64 * 64, 64);
          stage64_ld(vr, vc + (long)(kt + 1) * 64 * 64, 64);
        }
        f32x4 s[4][2];
        qk_tile<2>(s, Ks, qf, i, g);
        const bool cfull3 = ((kt * 64 + 63) * 16 + 31 <= t0) && (kt * 64 + 63 < 511);
        const float cg0 = ih[0] * gt[0][0], cg1 = ih[1] * gt[1][0];
#pragma unroll
        for (int kf = 0; kf < 4; ++kf)
#pragma unroll
          for (int r = 0; r < 4; ++r) {
            if (cfull3) {
              s[kf][0][r] = ex2(s[kf][0][r] - mh[0]) * cg0;
              s[kf][1][r] = ex2(s[kf][1][r] - mh[1]) * cg1;
            } else {
              int key = kt * 64 + 16 * kf + 4 * g + r;
              bool ok = (key * 16 + 31 <= tl) && key < 511;
              s[kf][0][r] = ok ? ex2(s[kf][0][r] - mh[0]) * cg0 : 0.f;
              s[kf][1][r] = ok ? ex2(s[kf][1][r] - mh[1]) * cg1 : 0.f;
            }
          }
        pv_tile(out, Vs, s, i, g);
      }
    }
#pragma unroll 1
    for (int br = 1; br < 3; ++br) {
      f32x4 o[4][2];
      float m[2], l[2];
#pragma unroll
      for (int h = 0; h < 2; ++h) {
        m[h] = -1e30f; l[h] = 0.f;
#pragma unroll
        for (int df = 0; df < 4; ++df) o[df][h] = (f32x4){0.f, 0.f, 0.f, 0.f};
      }
      const int jw0 = t0 >= 512 ? 0 : (512 - t0) >> 6;
      const int ntile = br == 1 ? nsel : 9 - jw0;
      const int kcol = br == 1 ? C_KS : C_KW, vcol = br == 1 ? C_VS : C_VW;
      auto tile_tok = [&](int idx) -> int {
        if (br == 1) return 64 * __builtin_amdgcn_readfirstlane((int)ldsu(lst + 4 + idx * 4));
        return t0 - 512 + 64 * (jw0 + idx);
      };
      u32x4 kr[2], vr[2];
      int ktn = tile_tok(0);
      stage64_ld(kr, p.proj + (rowb + ktn) * NP + kcol, NP);
      stage64_ld(vr, p.proj + (rowb + ktn) * NP + vcol, NP);
      for (int idx = 0; idx < ntile; ++idx) {
        const int kt0 = ktn;
        __syncthreads();
        stage64_st(kr, Ks);
        stage64_st(vr, Vs);
        __syncthreads();
        if (idx + 1 < ntile) {
          ktn = tile_tok(idx + 1);
          stage64_ld(kr, p.proj + (rowb + ktn) * NP + kcol, NP);
          stage64_ld(vr, p.proj + (rowb + ktn) * NP + vcol, NP);
        }
        bool selbit = true;
        if (br == 1) {
          int j = kt0 >> 6;
          unsigned mw = j < 32 ? mysel[0] : (j < 64 ? mysel[1] : (j < 96 ? mysel[2] : mysel[3]));
          selbit = (mw >> (j & 31)) & 1u;
        }
        if (br == 1 && !__any(selbit)) continue;
        f32x4 s[4][2];
        qk_tile<2>(s, Ks, qf, i, g);
        const bool full = (kt0 + 63 <= t0) && (br == 1 || kt0 >= t0 - 448);
        if (full) {
          if (br == 1) osm_update_full<true>(s, selbit, m, l, o);
          else osm_update_full<false>(s, true, m, l, o);
        } else {
          bool vm[4][4];
#pragma unroll
          for (int kf = 0; kf < 4; ++kf)
#pragma unroll
            for (int r = 0; r < 4; ++r) {
              int ktok = kt0 + 16 * kf + 4 * g + r;
              vm[kf][r] = br == 1 ? (selbit && ktok <= tl) : (ktok <= tl && ktok > tl - 512);
            }
          osm_update(s, vm, m, l, o);
        }
        pv_tile(o, Vs, s, i, g);
      }
#pragma unroll
      for (int h = 0; h < 2; ++h) {
        float lt = l[h];
        lt += __shfl_xor(lt, 16);
        lt += __shfl_xor(lt, 32);
        float cc = (br == 1 ? gt[h][1] : gt[h][2]) / fmaxf(lt, 1e-20f);
#pragma unroll
        for (int df = 0; df < 4; ++df) out[df][h] += o[df][h] * cc;
      }
    }
#pragma unroll
    for (int h = 0; h < 2; ++h)
#pragma unroll
      for (int df = 0; df < 4; ++df) {
        u32x2 ov;
        ov.x = pk2(out[df][h][0], out[df][h][1]);
        ov.y = pk2(out[df][h][2], out[df][h][3]);
        *(u32x2*)(p.ymix + slab_idx(rowl, 768 + (2 * hp + h) * 64 + 16 * df + 4 * g, NTOK)) = ov;
      }
  }
}

#define XB_TMO      128
#define XB_XCNT(j)  (256  + 64 * (j))
#define XB_XSUB(j)  (1280 + 64 * (j))
#define XB_XGEN(j)  (2304 + 64 * (j))
#define XB_TOP      3328
#define XB_TOPGEN   3392
#define XCD_BAR_WORDS 3456
#define XB_SPIN_CAP (1u << 22)
__device__ __forceinline__ unsigned xb_ld(unsigned* p) { return __hip_atomic_load(p, __ATOMIC_RELAXED, __HIP_MEMORY_SCOPE_AGENT); }
__device__ __forceinline__ unsigned xb_add(unsigned* p, unsigned v) { return __hip_atomic_fetch_add(p, v, __ATOMIC_RELAXED, __HIP_MEMORY_SCOPE_AGENT); }
__device__ __forceinline__ unsigned xb_xcc_id() { return (unsigned)__builtin_amdgcn_s_getreg((3 << 11) | 20) & 0xFu; }
#define XB_SPIN(cond, bar) do { unsigned _sp = 0; while (cond) { __builtin_amdgcn_s_sleep(1); \
    if ((++_sp & 255u) == 0u) { if (xb_ld(&(bar)[XB_TMO])) break; if (_sp > XB_SPIN_CAP) { atomicAdd(&(bar)[XB_TMO], 1u); break; } } } } while (0)
struct XcdBarrier { unsigned* bar; unsigned x; volatile LAS unsigned* st; };
__device__ __forceinline__ XcdBarrier xcd_barrier_post(unsigned* bar, volatile LAS unsigned* st) {
  XcdBarrier b; b.bar = bar; b.x = xb_xcc_id(); b.st = st;
  if (threadIdx.x == 0) (void)xb_add(&bar[XB_XCNT(b.x)], 1u);
  return b;
}
__device__ __forceinline__ void xcd_barrier_complete(unsigned* bar, unsigned x, unsigned& nloc, unsigned& nx) {
  const unsigned G = gridDim.x * gridDim.y * gridDim.z;
  unsigned sum, cnt, mine, sp = 0u;
  for (;;) {
    sum = 0u; cnt = 0u; mine = 0u;
#pragma unroll
    for (unsigned j = 0; j < 16; ++j) { const unsigned c = xb_ld(&bar[XB_XCNT(j)]); sum += c; cnt += (c > 0u) ? 1u : 0u; mine = (j == x) ? c : mine; }
    if (sum == G) break;
    __builtin_amdgcn_s_sleep(1);
    if ((++sp & 255u) == 0u) { if (xb_ld(&bar[XB_TMO])) break; if (sp > XB_SPIN_CAP) { atomicAdd(&bar[XB_TMO], 1u); break; } }
  }
  nloc = mine > 0u ? mine : 1u; nx = cnt > 0u ? cnt : 1u;
}
__device__ __forceinline__ void xcd_barrier(const XcdBarrier& b) {
  asm volatile("s_waitcnt vmcnt(0)" ::: "memory");
  __syncthreads();
  if (threadIdx.x == 0) {
    unsigned* bar = b.bar;
    __builtin_amdgcn_s_waitcnt(0);
    unsigned nloc = b.st[0], nx = b.st[1];
    if (nloc == 0u) { xcd_barrier_complete(bar, b.x, nloc, nx); b.st[0] = nloc; b.st[1] = nx; }
    const unsigned old = xb_add(&bar[XB_XSUB(b.x)], 1u);
    const unsigned gen = old / nloc;
    if (old + 1u == (gen + 1u) * nloc) {
      __builtin_amdgcn_fence(__ATOMIC_RELEASE, "agent");
      asm volatile("s_waitcnt vmcnt(0)" ::: "memory");
      const unsigned og = xb_add(&bar[XB_TOP], 1u);
      const unsigned tg = og / nx;
      if (og + 1u == (tg + 1u) * nx) xb_add(&bar[XB_TOPGEN], 1u);
      else XB_SPIN(xb_ld(&bar[XB_TOPGEN]) == tg, bar);
      __builtin_amdgcn_fence(__ATOMIC_ACQUIRE, "agent");
      xb_add(&bar[XB_XGEN(b.x)], 1u);
      asm volatile("s_waitcnt vmcnt(0)" ::: "memory");
    } else {
      XB_SPIN(xb_ld(&bar[XB_XGEN(b.x)]) == gen, bar);
      __builtin_amdgcn_fence(__ATOMIC_ACQUIRE, "agent");
      asm volatile("s_waitcnt vmcnt(0)" ::: "memory");
    }
  }
  __syncthreads();
}

enum { PH_CONV = 0, PH_INPROJ, PH_MIX1, PH_MIX2, PH_MIX3, PH_OUTPROJ, PH_UP, PH_DOWN, PH_FINAL };

__device__ __forceinline__ void run_phase(const P& p, int ph, int layer, ldsp smem) {
  switch (ph) {
    case PH_CONV: ph_convert(p, smem); ph_prepass(p); break;
    case PH_INPROJ: ph_inproj(p, layer, smem); break;
    case PH_MIX1:
      if (gridDim.x > 64) {
        if (blockIdx.x < 32) cmp_gemm1_tile(p, layer, blockIdx.x, smem);
        else for (int it = blockIdx.x - 32; it < 1024; it += gridDim.x - 32) ssd1_item(p, layer, it, smem);
      } else {
        for (int it = blockIdx.x; it < 32; it += gridDim.x) cmp_gemm1_tile(p, layer, it, smem);
        for (int it = blockIdx.x; it < 1024; it += gridDim.x) ssd1_item(p, layer, it, smem);
      }
      for (int it = blockIdx.x; it < 512; it += gridDim.x) shortconv_item(p, layer, it);
      break;
    case PH_MIX2:
      for (int it = blockIdx.x; it < 512; it += gridDim.x) ssd2_item(p, it);
      for (int it = blockIdx.x; it < 1024; it += gridDim.x) cmp_gemm2_item(p, layer, it);
      break;
    case PH_MIX3:
      for (int it = blockIdx.x; it < 1024; it += gridDim.x) nsa_item(p, layer, it, smem);
      for (int it = blockIdx.x; it < 512; it += gridDim.x) ssd3_item(p, layer, it, smem);
      break;
    case PH_OUTPROJ: ph_resgemm(p.ymix, DM, p.WoutT + (long)layer * DM * DM, p.h, p.ssqp, smem); break;
    case PH_UP: ph_ffn_up(p, layer, smem); break;
    case PH_DOWN: ph_resgemm(p.act, DFF, p.WdownT + (long)layer * DM * DFF, p.h, p.ssqp, smem); break;
    case PH_FINAL: ph_final(p); break;
  }
}

#if SINGLE_LAUNCH
__global__ void __launch_bounds__(256, 2) k_all(P p) {
  extern __shared__ __attribute__((aligned(16))) unsigned char lds_raw[];
  ldsp smem = (ldsp)lds_raw;
  cg::grid_group grid = cg::this_grid();
  volatile LAS unsigned* st = (volatile LAS unsigned*)(smem + LDS_MAIN);
  if (threadIdx.x < 4) st[threadIdx.x] = 0u;
  __syncthreads();
  XcdBarrier xb = xcd_barrier_post(p.bar, st);
  constexpr int NSTEP = 2 + NLAYER * 7;
  for (int step = 0; step < NSTEP; ++step) {
    int ph, layer;
    if (step == 0) { ph = PH_CONV; layer = 0; }
    else if (step == NSTEP - 1) { ph = PH_FINAL; layer = 0; }
    else { layer = (step - 1) / 7; ph = PH_INPROJ + (step - 1) % 7; }
    const int reps = (ph == REP_PH) ? 2 : 1;
    for (int r = 0; r < reps; ++r) run_phase(p, ph, layer, smem);
    if (step == 0) grid.sync();
    else if (step + 1 < NSTEP) xcd_barrier(xb);
  }
}
#define KMAIN k_all
#else
__global__ void __launch_bounds__(256, 2) k_phase(P p, int ph, int layer) {
  extern __shared__ __attribute__((aligned(16))) unsigned char lds_raw[];
  run_phase(p, ph, layer, (ldsp)lds_raw);
}
#define KMAIN k_phase
#endif

extern "C" void kernel_launch(void* const* d_in, const int* in_sizes, int n_in, void* d_out, int out_size, void* d_ws,
                              size_t ws_size, hipStream_t stream) {
  static int grid_blocks = 0;
  if (!grid_blocks) {
    int dev = 0, cus = 0, per_cu = 0;
    (void)hipGetDevice(&dev);
    (void)hipDeviceGetAttribute(&cus, hipDeviceAttributeMultiprocessorCount, dev);
    (void)hipFuncSetAttribute((const void*)KMAIN, hipFuncAttributeMaxDynamicSharedMemorySize, LDS_BYTES);
    (void)hipOccupancyMaxActiveBlocksPerMultiprocessor(&per_cu, (const void*)KMAIN, 256, LDS_BYTES);
    if (per_cu < 1) per_cu = 1;
    if (per_cu > 2) per_cu = 2;
    grid_blocks = cus * per_cu;
  }
  P p{};
  const float** pin = (const float**)&p;
  for (int q = 0; q < 23; ++q) pin[q] = (const float*)d_in[q];
  p.out = (float*)d_out;
  unsigned char* ws = (unsigned char*)d_ws;
  size_t off = 0;
  auto take = [&](size_t bytes) { unsigned char* r = ws + off; off += (bytes + 255) & ~(size_t)255; return r; };
  p.WinT = (bf16_t*)take((size_t)NLAYER * NP * DM * 2);
  p.WoutT = (bf16_t*)take((size_t)NLAYER * DM * DM * 2);
  p.WupT = (bf16_t*)take((size_t)NLAYER * 5632 * DM * 2);
  p.WdownT = (bf16_t*)take((size_t)NLAYER * DM * DFF * 2);
  p.W1T = (bf16_t*)take((size_t)NLAYER * 2 * 128 * 2048 * 2);
  p.zeros = (bf16_t*)take(4096);
  p.cwh = (bf16_t*)take((size_t)NLAYER * 5 * 1024 * 2);
  p.c1 = (float*)take(NLAYER * 2 * 128 * 4);
  p.rope = (float*)take((size_t)SEQ * 64 * 4);
  p.cdec = (float*)take(4 * 128 * 8 * 4);
  p.bar = (unsigned*)take(XCD_BAR_WORDS * 4);
  p.ssqp = (float*)take((size_t)NTOK * 8 * 4);
  p.hid = (bf16_t*)take((size_t)2 * 2048 * 128 * 2);
  p.kcvc = (bf16_t*)take((size_t)2 * 2048 * 64 * 2);
  p.h = (bf16_t*)take((size_t)NTOK * DM * 2);
  p.states = (bf16_t*)take((size_t)NTOK * DM * 2);
  p.proj = (bf16_t*)take((size_t)NTOK * NP * 2);
  p.act = p.proj;
  p.ymix = (bf16_t*)take((size_t)NTOK * DM * 2);
  if (off > ws_size) { fprintf(stderr, "workspace too small: need %zu have %zu\n", off, ws_size); return; }
#if SINGLE_LAUNCH
  (void)hipMemsetAsync(p.bar, 0, XCD_BAR_WORDS * 4, stream);
  void* args[] = {&p};
  hipError_t e = hipLaunchCooperativeKernel((const void*)k_all, dim3(grid_blocks), dim3(256), args, LDS_BYTES, stream);
  if (e != hipSuccess) fprintf(stderr, "cooperative launch failed: %s (grid %d)\n", hipGetErrorString(e), grid_blocks);
#else
  k_phase<<<grid_blocks, 256, LDS_BYTES, stream>>>(p, PH_CONV, 0);
  for (int layer = 0; layer < NLAYER; ++layer)
    for (int ph = PH_INPROJ; ph <= PH_DOWN; ++ph) k_phase<<<grid_blocks, 256, LDS_BYTES, stream>>>(p, ph, layer);
  k_phase<<<grid_blocks, 256, LDS_BYTES, stream>>>(p, PH_FINAL, 0);
#endif
}
```

```cpp
#include <hip/hip_runtime.h>
#include <hip/hip_cooperative_groups.h>
#include <cstdio>
namespace cg = cooperative_groups;

#ifndef REP_PH
#define REP_PH -1
#endif
#ifndef SINGLE_LAUNCH
#define SINGLE_LAUNCH 1
#endif

typedef unsigned short bf16_t;
typedef short bf16x8 __attribute__((ext_vector_type(8)));
typedef short s16x4 __attribute__((ext_vector_type(4)));
typedef short v4i16_t __attribute__((ext_vector_type(4)));
typedef float f32x4 __attribute__((ext_vector_type(4)));
typedef unsigned u32x4 __attribute__((ext_vector_type(4)));
typedef unsigned u32x2 __attribute__((ext_vector_type(2)));
#define LAS __attribute__((address_space(3)))
typedef LAS unsigned char* ldsp;

constexpr int NTOK = 32768, SEQ = 8192, DM = 1024, NP = 3072, DFF = 2752, NLAYER = 4;
constexpr int LDS_MAIN = 73728;
constexpr int LDS_BYTES = LDS_MAIN + 16;
constexpr int C_Z = 0, C_XBC = 512, C_SCB = 1536, C_SCC = 1792, C_SCH = 2048, C_Q = 2304, C_KC = 2560, C_VC = 2624,
              C_KS = 2688, C_VS = 2752, C_KW = 2816, C_VW = 2880, C_DT = 2944, C_G = 2952;

struct P {
  const float *x, *attn_norm_w, *w_in, *ssd_conv_w, *ssd_conv_b, *ssd_dt_bias, *ssd_a_log, *ssd_d, *ssd_norm_w, *sc_conv_w,
      *cmp_k_pos, *cmp_k_w1, *cmp_k_w2, *cmp_v_pos, *cmp_v_w1, *cmp_v_w2, *w_out, *ffn_norm_w, *ffn_w_up, *ffn_conv_w,
      *ffn_conv_b, *ffn_w_down, *final_norm_w;
  float* out;
  bf16_t *WinT, *WoutT, *WupT, *WdownT, *W1T, *zeros, *h, *proj, *ymix, *act, *states, *hid, *kcvc;
  float *c1, *rope, *cdec, *ssqp;
  unsigned* bar;
  bf16_t* cwh;
};

__device__ __forceinline__ int tidx() { int t = threadIdx.x; asm volatile("" : "+v"(t)); return t; }
typedef _Float16 h16x8 __attribute__((ext_vector_type(8)));
typedef _Float16 h16x2 __attribute__((ext_vector_type(2)));
__device__ __forceinline__ bf16_t f2bf(float f) { _Float16 h = (_Float16)f; return __builtin_bit_cast(unsigned short, h); }
__device__ __forceinline__ float bf2f(bf16_t b) { return (float)__builtin_bit_cast(_Float16, b); }
__device__ __forceinline__ unsigned pk2(float a, float b) { return __builtin_bit_cast(unsigned, __builtin_amdgcn_cvt_pkrtz(a, b)); }
__device__ __forceinline__ h16x2 as_h2(unsigned u) { return __builtin_bit_cast(h16x2, u); }
__device__ __forceinline__ float bflo(unsigned u) { return (float)__builtin_bit_cast(h16x2, u).x; }
__device__ __forceinline__ float bfhi(unsigned u) { return (float)__builtin_bit_cast(h16x2, u).y; }
__device__ __forceinline__ bf16x8 pack8(const float* v) {
  u32x4 u;
  u.x = pk2(v[0], v[1]); u.y = pk2(v[2], v[3]); u.z = pk2(v[4], v[5]); u.w = pk2(v[6], v[7]);
  return __builtin_bit_cast(bf16x8, u);
}
__device__ __forceinline__ bf16x8 pack44(f32x4 a, f32x4 b) {
  u32x4 u;
  u.x = pk2(a[0], a[1]); u.y = pk2(a[2], a[3]); u.z = pk2(b[0], b[1]); u.w = pk2(b[2], b[3]);
  return __builtin_bit_cast(bf16x8, u);
}
__device__ __forceinline__ bf16x8 pack44_rtz(f32x4 a, f32x4 b) {
  u32x4 u;
  u.x = __builtin_bit_cast(unsigned, __builtin_amdgcn_cvt_pkrtz(a[0], a[1])); u.y = __builtin_bit_cast(unsigned, __builtin_amdgcn_cvt_pkrtz(a[2], a[3]));
  u.z = __builtin_bit_cast(unsigned, __builtin_amdgcn_cvt_pkrtz(b[0], b[1])); u.w = __builtin_bit_cast(unsigned, __builtin_amdgcn_cvt_pkrtz(b[2], b[3]));
  return __builtin_bit_cast(bf16x8, u);
}
__device__ __forceinline__ void unpack8(u32x4 u, float* v) {
  v[0] = bflo(u.x); v[1] = bfhi(u.x); v[2] = bflo(u.y); v[3] = bfhi(u.y);
  v[4] = bflo(u.z); v[5] = bfhi(u.z); v[6] = bflo(u.w); v[7] = bfhi(u.w);
}
__device__ __forceinline__ bf16x8 ld128(ldsp p) { return *(LAS const bf16x8*)p; }
__device__ __forceinline__ void st128(ldsp p, u32x4 v) { *(LAS u32x4*)p = v; }
__device__ __forceinline__ s16x4 ldtr(ldsp p) {
  return __builtin_bit_cast(s16x4, __builtin_amdgcn_ds_read_tr16_b64_v4i16((LAS v4i16_t*)p));
}
__device__ __forceinline__ bf16x8 cat4(s16x4 a, s16x4 b) {
  bf16x8 r;
  r[0] = a[0]; r[1] = a[1]; r[2] = a[2]; r[3] = a[3]; r[4] = b[0]; r[5] = b[1]; r[6] = b[2]; r[7] = b[3];
  return r;
}
__device__ __forceinline__ float ldsf(ldsp p) { return *(LAS const float*)p; }
__device__ __forceinline__ unsigned ldsu(ldsp p) { return *(LAS const unsigned*)p; }
__device__ __forceinline__ void stsf(ldsp p, float v) { *(LAS float*)p = v; }
__device__ __forceinline__ void stsu(ldsp p, unsigned v) { *(LAS unsigned*)p = v; }
__device__ __forceinline__ f32x4 mfma16(bf16x8 a, bf16x8 b, f32x4 c) {
  return __builtin_amdgcn_mfma_f32_16x16x32_f16(__builtin_bit_cast(h16x8, a), __builtin_bit_cast(h16x8, b), c, 0, 0, 0);
}
__device__ __forceinline__ float ex2(float x) { return __builtin_amdgcn_exp2f(x); }
__device__ __forceinline__ float siluf(float x) { return x * __builtin_amdgcn_rcpf(1.f + __expf(-x)); }
__device__ __forceinline__ float sigmf(float x) { return __builtin_amdgcn_rcpf(1.f + __expf(-x)); }
__device__ __forceinline__ float softplusf(float x) { return x > 20.f ? x : log1pf(expf(x)); }
__device__ __forceinline__ float geluf(float x) {
  float u = 0.7978845608028654f * (x + 0.044715f * x * x * x);
  return 0.5f * x * (1.f + tanhf(u));
}
__device__ __forceinline__ u32x4 gld128(const bf16_t* p) { return *(const u32x4*)p; }
__device__ __forceinline__ long slab_idx(long row, int col, long nrows) { return ((long)(col >> 5) * nrows + row) * 32 + (col & 31); }

__device__ __forceinline__ int map_win(int n) {
  if (n < 1536) return n;
  if (n < 2944) return n + 8;
  if (n < 2952) return n - 2944 + 1536;
  if (n < 2964) return n;
  return -1;
}
__device__ __forceinline__ int map_wup(int n) {
  int j = n >> 7, r = n & 127;
  if (j >= 43) return -1;
  return r < 64 ? 64 * j + r : DFF + 64 * j + (r - 64);
}
__device__ __forceinline__ void transpose_tile(const float* src, int Nsrc, bf16_t* dst, int Ndst, int n0, int k0, int kind, ldsp smem,
                                               const float* kscale = nullptr) {
  const int tid = tidx();
  __syncthreads();
  {
    int nn = tid & 63;
    int n = n0 + nn;
    int sc = kind == 0 ? n : (kind == 1 ? map_win(n) : map_wup(n));
    for (int it = 0; it < 16; ++it) {
      int k = it * 4 + (tid >> 6);
      float v = sc >= 0 ? src[(long)(k0 + k) * Nsrc + sc] : 0.f;
      if (kscale) v *= kscale[k0 + k];
      stsf(smem + (k * 65 + nn) * 4, v);
    }
  }
  __syncthreads();
  {
    int nn = tid >> 2, kc = (tid & 3) * 16;
    float v[16];
    for (int e = 0; e < 16; ++e) v[e] = ldsf(smem + ((kc + e) * 65 + nn) * 4);
    u32x4 a, b;
    a.x = pk2(v[0], v[1]); a.y = pk2(v[2], v[3]); a.z = pk2(v[4], v[5]); a.w = pk2(v[6], v[7]);
    b.x = pk2(v[8], v[9]); b.y = pk2(v[10], v[11]); b.z = pk2(v[12], v[13]); b.w = pk2(v[14], v[15]);
    bf16_t* d = dst + slab_idx(n0 + nn, k0 + kc, Ndst);
    *(u32x4*)d = a;
    *(u32x4*)(d + 8) = b;
  }
}

constexpr int CV_WIN = 48 * 16, CV_WOUT = 16 * 16, CV_WUP = 88 * 16, CV_WDN = 16 * 43, CV_W1 = 2 * 32;
constexpr int CV_LAYER = CV_WIN + CV_WOUT + CV_WUP + CV_WDN + 2 * CV_W1;
constexpr int CV_ROPE = 1024, CV_C1 = 8, CV_TOTAL = NLAYER * CV_LAYER + CV_ROPE + CV_C1 + 1;

struct TDesc { const float* src; const float* kscale; bf16_t* dst; int Nsrc, Ndst, n0, k0, kind; };
__device__ __forceinline__ TDesc conv_desc(const P& p, int it) {
  TDesc d; d.kscale = nullptr; d.kind = 0;
  int l = it / CV_LAYER, r = it % CV_LAYER;
  if (r < CV_WIN) {
    d.src = p.w_in + (long)l * DM * 2964; d.Nsrc = 2964; d.dst = p.WinT + (long)l * NP * DM; d.Ndst = NP; d.n0 = (r / 16) * 64; d.k0 = (r % 16) * 64; d.kind = 1; d.kscale = p.attn_norm_w + l * DM;
  } else if ((r -= CV_WIN) < CV_WOUT) {
    d.src = p.w_out + (long)l * DM * DM; d.Nsrc = DM; d.dst = p.WoutT + (long)l * DM * DM; d.Ndst = DM; d.n0 = (r / 16) * 64; d.k0 = (r % 16) * 64;
  } else if ((r -= CV_WOUT) < CV_WUP) {
    d.src = p.ffn_w_up + (long)l * DM * 2 * DFF; d.Nsrc = 2 * DFF; d.dst = p.WupT + (long)l * 5632 * DM; d.Ndst = 5632; d.n0 = (r / 16) * 64; d.k0 = (r % 16) * 64; d.kind = 2; d.kscale = p.ffn_norm_w + l * DM;
  } else if ((r -= CV_WUP) < CV_WDN) {
    d.src = p.ffn_w_down + (long)l * DFF * DM; d.Nsrc = DM; d.dst = p.WdownT + (long)l * DM * DFF; d.Ndst = DM; d.n0 = (r / 43) * 64; d.k0 = (r % 43) * 64;
  } else if ((r -= CV_WDN) < CV_W1) {
    d.src = p.cmp_k_w1 + (long)l * 2048 * 128; d.Nsrc = 128; d.dst = p.W1T + (long)(l * 2 + 0) * 128 * 2048; d.Ndst = 128; d.n0 = (r / 32) * 64; d.k0 = (r % 32) * 64;
  } else {
    r -= CV_W1;
    d.src = p.cmp_v_w1 + (long)l * 2048 * 128; d.Nsrc = 128; d.dst = p.W1T + (long)(l * 2 + 1) * 128 * 2048; d.Ndst = 128; d.n0 = (r / 32) * 64; d.k0 = (r % 32) * 64;
  }
  return d;
}
__device__ __forceinline__ void transpose_group4(const P& p, int it0, ldsp smem) {
  const int tid = tidx();
  const int n4 = (tid & 15) * 4, kr = tid >> 4;
  float4 v[4][4];
  TDesc d[4];
#pragma unroll
  for (int t = 0; t < 4; ++t) {
    d[t] = conv_desc(p, it0 + t);
    const int n = d[t].n0 + n4;
    const int sc = d[t].kind == 0 ? n : (d[t].kind == 1 ? map_win(n) : map_wup(n));
#pragma unroll
    for (int q = 0; q < 4; ++q) {
      const int k = d[t].k0 + kr + 16 * q;
      v[t][q] = sc >= 0 ? *(const float4*)(d[t].src + (long)k * d[t].Nsrc + sc) : make_float4(0.f, 0.f, 0.f, 0.f);
      if (d[t].kscale) { const float ks = d[t].kscale[k]; v[t][q].x *= ks; v[t][q].y *= ks; v[t][q].z *= ks; v[t][q].w *= ks; }
    }
  }
  __syncthreads();
#pragma unroll
  for (int t = 0; t < 4; ++t)
#pragma unroll
    for (int q = 0; q < 4; ++q) {
      const ldsp b = smem + t * 16640 + ((kr + 16 * q) * 65 + n4) * 4;
      stsf(b, v[t][q].x); stsf(b + 4, v[t][q].y); stsf(b + 8, v[t][q].z); stsf(b + 12, v[t][q].w);
    }
  __syncthreads();
#pragma unroll
  for (int t = 0; t < 4; ++t) {
    const int nn = tid >> 2, kc = (tid & 3) * 16;
    float w[16];
#pragma unroll
    for (int e = 0; e < 16; ++e) w[e] = ldsf(smem + t * 16640 + ((kc + e) * 65 + nn) * 4);
    u32x4 a, b;
    a.x = pk2(w[0], w[1]); a.y = pk2(w[2], w[3]); a.z = pk2(w[4], w[5]); a.w = pk2(w[6], w[7]);
    b.x = pk2(w[8], w[9]); b.y = pk2(w[10], w[11]); b.z = pk2(w[12], w[13]); b.w = pk2(w[14], w[15]);
    bf16_t* dp = d[t].dst + slab_idx(d[t].n0 + nn, d[t].k0 + kc, d[t].Ndst);
    *(u32x4*)dp = a;
    *(u32x4*)(dp + 8) = b;
  }
}
__device__ __forceinline__ void ph_convert(const P& p, ldsp smem) {
  const int tid = tidx();
  for (int gi = blockIdx.x; gi < NLAYER * CV_LAYER / 4; gi += gridDim.x) transpose_group4(p, gi * 4, smem);
  for (int it = NLAYER * CV_LAYER + blockIdx.x; it < CV_TOTAL; it += gridDim.x) {
    if (it < NLAYER * CV_LAYER) {
      int l = it / CV_LAYER, r = it % CV_LAYER;
      if (r < CV_WIN) {
        transpose_tile(p.w_in + (long)l * DM * 2964, 2964, p.WinT + (long)l * NP * DM, NP, (r / 16) * 64, (r % 16) * 64, 1, smem, p.attn_norm_w + l * DM);
      } else if ((r -= CV_WIN) < CV_WOUT) {
        transpose_tile(p.w_out + (long)l * DM * DM, DM, p.WoutT + (long)l * DM * DM, DM, (r / 16) * 64, (r % 16) * 64, 0, smem);
      } else if ((r -= CV_WOUT) < CV_WUP) {
        transpose_tile(p.ffn_w_up + (long)l * DM * 2 * DFF, 2 * DFF, p.WupT + (long)l * 5632 * DM, 5632, (r / 16) * 64, (r % 16) * 64, 2, smem, p.ffn_norm_w + l * DM);
      } else if ((r -= CV_WUP) < CV_WDN) {
        transpose_tile(p.ffn_w_down + (long)l * DFF * DM, DM, p.WdownT + (long)l * DM * DFF, DM, (r / 43) * 64, (r % 43) * 64, 0, smem);
      } else if ((r -= CV_WDN) < CV_W1) {
        transpose_tile(p.cmp_k_w1 + (long)l * 2048 * 128, 128, p.W1T + (long)(l * 2 + 0) * 128 * 2048, 128, (r / 32) * 64, (r % 32) * 64, 0, smem);
      } else {
        r -= CV_W1;
        transpose_tile(p.cmp_v_w1 + (long)l * 2048 * 128, 128, p.W1T + (long)(l * 2 + 1) * 128 * 2048, 128, (r / 32) * 64, (r % 32) * 64, 0, smem);
      }
    } else {
      int r = it - NLAYER * CV_LAYER;
      if (r < CV_ROPE) {
        int idx = r * 256 + tid;
        int t = idx >> 5, d = idx & 31;
        float inv = 1.0f / powf(10000.0f, (float)d / 32.0f);
        float ang = (float)t * inv;
        p.rope[t * 64 + d] = cosf(ang);
        p.rope[t * 64 + 32 + d] = sinf(ang);
      } else if ((r -= CV_ROPE) < CV_C1) {
        int l = r >> 1, kv = r & 1;
        const float* pos = (kv ? p.cmp_v_pos : p.cmp_k_pos) + (long)l * 2048;
        const float* w1 = (kv ? p.cmp_v_w1 : p.cmp_k_w1) + (long)l * 2048 * 128;
        const int n4 = (tid & 31) * 4, kg = tid >> 5;
        float4 ac = make_float4(0.f, 0.f, 0.f, 0.f);
#pragma unroll 8
        for (int k = kg * 256; k < kg * 256 + 256; ++k) {
          const float pk = pos[k];
          const float4 wv4 = *(const float4*)(w1 + (long)k * 128 + n4);
          ac.x += pk * wv4.x; ac.y += pk * wv4.y; ac.z += pk * wv4.z; ac.w += pk * wv4.w;
        }
        __syncthreads();
        stsf(smem + (kg * 128 + n4) * 4, ac.x); stsf(smem + (kg * 128 + n4 + 1) * 4, ac.y);
        stsf(smem + (kg * 128 + n4 + 2) * 4, ac.z); stsf(smem + (kg * 128 + n4 + 3) * 4, ac.w);
        __syncthreads();
        if (tid < 128) {
          float sacc = 0.f;
#pragma unroll
          for (int gq = 0; gq < 8; ++gq) sacc += ldsf(smem + (gq * 128 + tid) * 4);
          p.c1[(l * 2 + kv) * 128 + tid] = sacc;
        }
      } else {
        for (int e = tid; e < 2048; e += 256) p.zeros[e] = 0;
        for (int e2 = tid; e2 < NLAYER * 5 * 512; e2 += 256) {
          const int e = 2 * e2, l2 = e / 5120, r2 = (e % 5120) >> 10, c2 = e & 1023;
          const float* src = r2 < 4 ? p.ssd_conv_w + (long)l2 * 4096 + r2 * 1024 + c2 : p.ssd_conv_b + l2 * 1024 + c2;
          ((unsigned*)p.cwh)[e2] = pk2(src[0], src[1]);
        }
      }
    }
  }
}

__device__ __forceinline__ void ph_prepass(const P& p) {
  const int wave = tidx() >> 6, lane = tidx() & 63;
  for (int row = blockIdx.x * 4 + wave; row < NTOK; row += gridDim.x * 4) {
    const float4* xr = (const float4*)(p.x + (long)row * DM);
    float ss = 0.f;
#pragma unroll
    for (int k = 0; k < 4; ++k) {
      float4 v = xr[lane + 64 * k];
      ss += v.x * v.x + v.y * v.y + v.z * v.z + v.w * v.w;
      u32x2 o; o.x = pk2(v.x, v.y); o.y = pk2(v.z, v.w);
      *(u32x2*)(p.h + slab_idx(row, (lane + 64 * k) * 4, NTOK)) = o;
    }
#pragma unroll
    for (int o = 32; o >= 1; o >>= 1) ss += __shfl_xor(ss, o);
    if (lane < 8) p.ssqp[(long)row * 8 + lane] = lane == 0 ? ss : 0.f;
  }
}
__device__ __forceinline__ float row_rstd(const float* ssqp, long row) {
  float4 a = *(const float4*)(ssqp + row * 8), b = *(const float4*)(ssqp + row * 8 + 4);
  float ss = ((a.x + a.y) + (a.z + a.w)) + ((b.x + b.y) + (b.z + b.w));
  return rsqrtf(ss * (1.f / 1024.f) + 1e-6f);
}
__device__ __forceinline__ void ph_final(const P& p) {
  const int wave = tidx() >> 6, lane = tidx() & 63;
  for (int row = blockIdx.x * 4 + wave; row < NTOK; row += gridDim.x * 4) {
    float4 v[4];
    float ss = 0.f;
#pragma unroll
    for (int k = 0; k < 4; ++k) {
      u32x2 hv = *(const u32x2*)(p.h + slab_idx(row, (lane + 64 * k) * 4, NTOK));
      v[k].x = bflo(hv.x); v[k].y = bfhi(hv.x); v[k].z = bflo(hv.y); v[k].w = bfhi(hv.y);
      ss += v[k].x * v[k].x + v[k].y * v[k].y + v[k].z * v[k].z + v[k].w * v[k].w;
    }
#pragma unroll
    for (int o = 32; o >= 1; o >>= 1) ss += __shfl_xor(ss, o);
    const float rstd = rsqrtf(ss * (1.f / 1024.f) + 1e-6f);
#pragma unroll
    for (int k = 0; k < 4; ++k) {
      float4 w4 = ((const float4*)p.final_norm_w)[lane + 64 * k];
      float4 o; o.x = v[k].x * rstd * w4.x; o.y = v[k].y * rstd * w4.y; o.z = v[k].z * rstd * w4.z; o.w = v[k].w * rstd * w4.w;
      ((float4*)(p.out + (long)row * DM))[lane + 64 * k] = o;
    }
  }
}
__device__ __forceinline__ void ph_rmsnorm(const float* x, const float* w, bf16_t* h, float* outf) {
  const int wave = tidx() >> 6, lane = tidx() & 63;
  for (int row = blockIdx.x * 4 + wave; row < NTOK; row += gridDim.x * 4) {
    const float4* xr = (const float4*)(x + (long)row * DM);
    float4 v[4];
    float ss = 0.f;
#pragma unroll
    for (int k = 0; k < 4; ++k) {
      v[k] = xr[lane + 64 * k];
      ss += v[k].x * v[k].x + v[k].y * v[k].y + v[k].z * v[k].z + v[k].w * v[k].w;
    }
#pragma unroll
    for (int o = 32; o >= 1; o >>= 1) ss += __shfl_xor(ss, o);
    float rstd = rsqrtf(ss * (1.f / 1024.f) + 1e-6f);
#pragma unroll
    for (int k = 0; k < 4; ++k) {
      float4 w4 = ((const float4*)w)[lane + 64 * k];
      float a = v[k].x * rstd * w4.x, b = v[k].y * rstd * w4.y, c = v[k].z * rstd * w4.z, d = v[k].w * rstd * w4.w;
      if (h) {
        u32x2 o; o.x = pk2(a, b); o.y = pk2(c, d);
        *(u32x2*)(h + slab_idx(row, (lane + 64 * k) * 4, NTOK)) = o;
      } else {
        float4 o; o.x = a; o.y = b; o.z = c; o.w = d;
        ((float4*)(outf + (long)row * DM))[lane + 64 * k] = o;
      }
    }
  }
}

constexpr int GSTAGE = 24576;
__device__ __forceinline__ int gemm_chunk_off() {
  const int t = tidx();
  const int sq = (t >> 4) & 3;
  const int sv = (0x78 >> (2 * sq)) & 3;
  return ((t & 3) ^ sv) * 8;
}
__device__ __forceinline__ const char* uniform_ptr(const char* p) {
  unsigned long long v = (unsigned long long)p;
  unsigned lo = __builtin_amdgcn_readfirstlane((unsigned)v), hi = __builtin_amdgcn_readfirstlane((unsigned)(v >> 32));
  asm volatile("" : "+s"(lo), "+s"(hi));
  return (const char*)(((unsigned long long)hi << 32) | lo);
}
template <bool CMPA>
__device__ __forceinline__ void gemm_core(f32x4 (&acc)[8][4], const char* abase, const unsigned (&voffA)[2], size_t astep, const char* bbase,
                                          const unsigned (&voffB)[4], size_t bstep, int nk, ldsp smem) {
  const int tid = tidx(), lane = tid & 63, wid = tid >> 6, wr = wid >> 1, wc = wid & 1, i = lane & 15, g = lane >> 4;
#pragma unroll
  for (int nf = 0; nf < 8; ++nf)
#pragma unroll
    for (int mf = 0; mf < 4; ++mf) acc[nf][mf] = (f32x4){0.f, 0.f, 0.f, 0.f};
  asm volatile("s_waitcnt vmcnt(0)" ::: "memory");
  __syncthreads();
  const int wbase = __builtin_amdgcn_readfirstlane(tid >> 6) * 1024;
  auto stage = [&](int kt, int buf) {
    const char* ak = uniform_ptr(abase + (CMPA ? ((size_t)(kt >> 1) * NP + (kt & 1) * 32) * 2 : (size_t)kt * astep));
    const char* bk = uniform_ptr(bbase + (size_t)kt * bstep);
#pragma unroll
    for (int q = 0; q < 2; ++q)
      __builtin_amdgcn_global_load_lds((const unsigned*)(ak + voffA[q]), (LAS unsigned*)(smem + buf * GSTAGE + wbase + q * 4096), 16, 0, 0);
#pragma unroll
    for (int q = 0; q < 4; ++q)
      __builtin_amdgcn_global_load_lds((const unsigned*)(bk + voffB[q]), (LAS unsigned*)(smem + buf * GSTAGE + 8192 + wbase + q * 4096), 16, 0, 0);
  };
  stage(0, 0);
  if (nk > 1) stage(1, 1);
  const int sq = (i >> 2) & 3;
  const int sw = (g ^ ((0x78 >> (2 * sq)) & 3)) * 16;
  int buf = 0, nbuf = 2;
  for (int kt = 0; kt < nk; ++kt) {
    if (kt + 1 < nk) asm volatile("s_waitcnt vmcnt(6)" ::: "memory");
    else asm volatile("s_waitcnt vmcnt(0)" ::: "memory");
    __builtin_amdgcn_s_barrier();
    asm volatile("" ::: "memory");
    ldsp sa = smem + buf * GSTAGE, sb = sa + 8192;
    bf16x8 a[4], b0[4];
#pragma unroll
    for (int mf = 0; mf < 4; ++mf) a[mf] = ld128(sa + (wr * 64 + mf * 16 + i) * 64 + sw);
#pragma unroll
    for (int nf = 0; nf < 4; ++nf) b0[nf] = ld128(sb + (wc * 128 + nf * 16 + i) * 64 + sw);
    bf16x8 b[4];
#pragma unroll
    for (int nf = 0; nf < 3; ++nf) b[nf] = ld128(sb + (wc * 128 + (4 + nf) * 16 + i) * 64 + sw);
    __builtin_amdgcn_s_setprio(1);
#pragma unroll
    for (int nf = 0; nf < 4; ++nf)
#pragma unroll
      for (int mf = 0; mf < 4; ++mf) acc[nf][mf] = mfma16(b0[nf], a[mf], acc[nf][mf]);
    __builtin_amdgcn_s_setprio(0);
    asm volatile("" ::: "memory");
    if (kt + 2 < nk) stage(kt + 2, nbuf);
    {
#pragma unroll
      for (int nf = 3; nf < 4; ++nf) b[nf] = ld128(sb + (wc * 128 + (4 + nf) * 16 + i) * 64 + sw);
      __builtin_amdgcn_s_setprio(1);
#pragma unroll
      for (int nf = 0; nf < 4; ++nf)
#pragma unroll
        for (int mf = 0; mf < 4; ++mf) acc[4 + nf][mf] = mfma16(b[nf], a[mf], acc[4 + nf][mf]);
      __builtin_amdgcn_s_setprio(0);
    }
    buf = buf == 2 ? 0 : buf + 1;
    nbuf = nbuf == 2 ? 0 : nbuf + 1;
  }
  __syncthreads();
}
__device__ __forceinline__ void tile_map(int t, int NT, int& mt, int& nt) {
  int xcd = t & 7, local = t >> 3;
  nt = local % NT;
  mt = (local / NT) * 8 + xcd;
}

__device__ __forceinline__ void ph_inproj(const P& p, int layer, ldsp smem) {
  const int tid = tidx(), lane = tid & 63, wid = tid >> 6, wr = wid >> 1, wc = wid & 1, i = lane & 15, g = lane >> 4;
  const bf16_t* Bt = p.WinT + (long)layer * NP * DM;
  const int co = gemm_chunk_off();
  for (int tile = blockIdx.x; tile < 256 * 12; tile += gridDim.x) {
    int mt, nt;
    tile_map(tile, 12, mt, nt);
    int m0 = mt * 128, n0 = nt * 256;
    unsigned voffA[2], voffB[4];
#pragma unroll
    for (int q = 0; q < 2; ++q) voffA[q] = (unsigned)(((tid >> 2) + 64 * q) * 32 + co) * 2u;
#pragma unroll
    for (int q = 0; q < 4; ++q) voffB[q] = (unsigned)(((tid >> 2) + 64 * q) * 32 + co) * 2u;
    f32x4 acc[8][4];
    gemm_core<false>(acc, (const char*)(p.h + (long)m0 * 32), voffA, (size_t)NTOK * 64, (const char*)(Bt + (long)n0 * 32), voffB, (size_t)NP * 64, DM / 32, smem);
#pragma unroll
    for (int mf = 0; mf < 4; ++mf) {
      const float rs = row_rstd(p.ssqp, m0 + wr * 64 + mf * 16 + i);
#pragma unroll
      for (int nf = 0; nf < 8; ++nf) acc[nf][mf] *= rs;
    }
#pragma unroll
    for (int hh = 0; hh < 2; ++hh) {
      int unit = (n0 + wc * 128 + hh * 64) >> 6;
      bool dorope = (unit >= 36 && unit <= 40) || unit == 42 || unit == 44;
      float qs = (unit >= 36 && unit <= 39) ? 0.125f * 1.4426950408889634f : 1.0f;
#pragma unroll
      for (int mf = 0; mf < 4; ++mf) {
        int row = m0 + wr * 64 + mf * 16 + i;
        if (dorope) {
          int t = row & (SEQ - 1);
#pragma unroll
          for (int n = 0; n < 2; ++n) {
            float4 c4 = *(const float4*)(p.rope + t * 64 + n * 16 + 4 * g);
            float4 s4 = *(const float4*)(p.rope + t * 64 + 32 + n * 16 + 4 * g);
            const float cc[4] = {c4.x, c4.y, c4.z, c4.w}, ss[4] = {s4.x, s4.y, s4.z, s4.w};
#pragma unroll
            for (int r = 0; r < 4; ++r) {
              float x1 = acc[hh * 4 + n][mf][r], x2 = acc[hh * 4 + n + 2][mf][r];
              acc[hh * 4 + n][mf][r] = (x1 * cc[r] - x2 * ss[r]) * qs;
              acc[hh * 4 + n + 2][mf][r] = (x2 * cc[r] + x1 * ss[r]) * qs;
            }
          }
        }
#pragma unroll
        for (int n = 0; n < 4; ++n) {
          f32x4 v = acc[hh * 4 + n][mf];
          u32x2 o; o.x = pk2(v[0], v[1]); o.y = pk2(v[2], v[3]);
          *(u32x2*)(p.proj + (long)row * NP + n0 + wc * 128 + (hh * 4 + n) * 16 + 4 * g) = o;
        }
      }
    }
  }
}

__device__ __forceinline__ void ph_resgemm(const bf16_t* A, int K, const bf16_t* Bt, bf16_t* hout, float* ssqp, ldsp smem) {
  const int tid = tidx(), lane = tid & 63, wid = tid >> 6, wr = wid >> 1, wc = wid & 1, i = lane & 15, g = lane >> 4;
  const int co = gemm_chunk_off();
  for (int tile = blockIdx.x; tile < 256 * 4; tile += gridDim.x) {
    int mt, nt;
    tile_map(tile, 4, mt, nt);
    int m0 = mt * 128, n0 = nt * 256;
    unsigned voffA[2], voffB[4];
#pragma unroll
    for (int q = 0; q < 2; ++q) voffA[q] = (unsigned)(((tid >> 2) + 64 * q) * 32 + co) * 2u;
#pragma unroll
    for (int q = 0; q < 4; ++q) voffB[q] = (unsigned)(((tid >> 2) + 64 * q) * 32 + co) * 2u;
    f32x4 acc[8][4];
    gemm_core<false>(acc, (const char*)(A + (long)m0 * 32), voffA, (size_t)NTOK * 64, (const char*)(Bt + (long)n0 * 32), voffB, (size_t)DM * 64, K / 32, smem);
#pragma unroll
    for (int mf = 0; mf < 4; ++mf) {
      long row = m0 + wr * 64 + mf * 16 + i;
      u32x2 xi[8];
#pragma unroll
      for (int nf = 0; nf < 8; ++nf) xi[nf] = *(const u32x2*)(hout + slab_idx(row, n0 + wc * 128 + nf * 16 + 4 * g, NTOK));
      float ss = 0.f;
#pragma unroll
      for (int nf = 0; nf < 8; ++nf) {
        f32x4 v = acc[nf][mf];
        float4 o; o.x = bflo(xi[nf].x) + v[0]; o.y = bfhi(xi[nf].x) + v[1]; o.z = bflo(xi[nf].y) + v[2]; o.w = bfhi(xi[nf].y) + v[3];
        ss += o.x * o.x + o.y * o.y + o.z * o.z + o.w * o.w;
        u32x2 hb; hb.x = pk2(o.x, o.y); hb.y = pk2(o.z, o.w);
        *(u32x2*)(hout + slab_idx(row, n0 + wc * 128 + nf * 16 + 4 * g, NTOK)) = hb;
      }
      ss += __shfl_xor(ss, 16);
      ss += __shfl_xor(ss, 32);
      if (g == 0) ssqp[row * 8 + nt * 2 + wc] = ss;
      asm volatile("" ::: "memory");
    }
  }
}

__device__ __forceinline__ void cmp_gemm1_tile(const P& p, int layer, int item, ldsp smem) {
  asm volatile("" : "+s"(layer));
  const int tid = tidx(), lane = tid & 63, wid = tid >> 6, wr = wid >> 1, wc = wid & 1, i = lane & 15, g = lane >> 4;
  const int co = gemm_chunk_off();
  int kv = item >> 4, mt = item & 15;
  int m0 = mt * 128;
  const bf16_t* A = p.proj + (kv ? C_VC : C_KC);
  const bf16_t* Bt = p.W1T + (long)(layer * 2 + kv) * 128 * 2048;
  unsigned voffA[2], voffB[4];
#pragma unroll
  for (int q = 0; q < 2; ++q) voffA[q] = (unsigned)(((tid >> 2) + 64 * q) * 16 * NP + co) * 2u;
#pragma unroll
  for (int q = 0; q < 4; ++q) voffB[q] = (unsigned)(((tid >> 2) + 64 * (q & 1)) * 32 + co) * 2u;
  f32x4 acc[8][4];
  gemm_core<true>(acc, (const char*)(A + (long)m0 * 16 * NP), voffA, 0, (const char*)Bt, voffB, (size_t)128 * 64, 64, smem);
  const float* c1 = p.c1 + (layer * 2 + kv) * 128;
  bf16_t* hid = p.hid + (long)kv * 2048 * 128;
  if (wc == 0) {
#pragma unroll
    for (int mf = 0; mf < 4; ++mf) {
      int row = m0 + wr * 64 + mf * 16 + i;
#pragma unroll
      for (int nf = 0; nf < 8; ++nf) {
        int col = nf * 16 + 4 * g;
        float4 cb = *(const float4*)(c1 + col);
        f32x4 v = acc[nf][mf];
        u32x2 o;
        o.x = pk2(geluf(v[0] + cb.x), geluf(v[1] + cb.y));
        o.y = pk2(geluf(v[2] + cb.z), geluf(v[3] + cb.w));
        *(u32x2*)(hid + (long)row * 128 + col) = o;
      }
    }
  }
}

__device__ __forceinline__ void ph_ffn_up(const P& p, int layer, ldsp smem) {
  const int tid = tidx(), lane = tid & 63, wid = tid >> 6, wr = wid >> 1, wc = wid & 1, i = lane & 15, g = lane >> 4;
  const int co = gemm_chunk_off();
  const bf16_t* Bt = p.WupT + (long)layer * 5632 * DM;
  const float* cw = p.ffn_conv_w + (long)layer * 3 * 2 * DFF;
  const float* cb = p.ffn_conv_b + (long)layer * 2 * DFF;
  constexpr int MT = 264, NT = 22;
  for (int tile = blockIdx.x; tile < MT * NT; tile += gridDim.x) {
    int mtb, nt;
    tile_map(tile, NT, mtb, nt);
    int b = mtb / 66, mj = mtb % 66;
    int tokbase = 126 * mj - 2;
    unsigned voffA[2], voffB[4];
#pragma unroll
    for (int q = 0; q < 2; ++q) {
      int tk = tokbase + (tid >> 2) + 64 * q;
      tk = tk < 0 ? 0 : (tk >= SEQ ? SEQ - 1 : tk);
      voffA[q] = (unsigned)(tk * 32 + co) * 2u;
    }
#pragma unroll
    for (int q = 0; q < 4; ++q) voffB[q] = (unsigned)(((tid >> 2) + 64 * q) * 32 + co) * 2u;
    f32x4 acc[8][4];
    gemm_core<false>(acc, (const char*)(p.h + (long)b * SEQ * 32), voffA, (size_t)NTOK * 64, (const char*)(Bt + (long)nt * 256 * 32), voffB, (size_t)5632 * 64, DM / 32, smem);
#pragma unroll
    for (int mf = 0; mf < 4; ++mf) {
      const int tkr = tokbase + wr * 64 + mf * 16 + i;
      const float rs = (tkr >= 0 && tkr < SEQ) ? row_rstd(p.ssqp, (long)b * SEQ + tkr) : 0.f;
#pragma unroll
      for (int nf = 0; nf < 8; ++nf) {
        int r = wr * 64 + mf * 16 + i, c = wc * 128 + nf * 16 + 4 * g;
        f32x4 v = acc[nf][mf] * rs;
        u32x2 o; o.x = pk2(v[0], v[1]); o.y = pk2(v[2], v[3]);
        *(LAS u32x2*)(smem + r * 528 + c * 2) = o;
      }
    }
    __syncthreads();
    {
      const int ac = (tid & 15) * 8;
      const int pi = ac >> 6, pc = ac & 63;
      const int pair = 2 * nt + pi;
      if (pair < 43) {
        const int gcol = pair * 64 + pc;
        const int lg = (pi * 128 + pc) * 2, lv = (pi * 128 + 64 + pc) * 2;
        h16x2 wg[3][4], wv[3][4], bg[4], bv[4];
#pragma unroll
        for (int q = 0; q < 4; ++q) {
#pragma unroll
          for (int j = 0; j < 3; ++j) {
            const float2 a2 = *(const float2*)(cw + j * 2 * DFF + gcol + 2 * q), b2 = *(const float2*)(cw + j * 2 * DFF + DFF + gcol + 2 * q);
            wg[j][q].x = (_Float16)a2.x; wg[j][q].y = (_Float16)a2.y;
            wv[j][q].x = (_Float16)b2.x; wv[j][q].y = (_Float16)b2.y;
          }
          const float2 c2 = *(const float2*)(cb + gcol + 2 * q), d2 = *(const float2*)(cb + DFF + gcol + 2 * q);
          bg[q].x = (_Float16)c2.x; bg[q].y = (_Float16)c2.y;
          bv[q].x = (_Float16)d2.x; bv[q].y = (_Float16)d2.y;
        }
#pragma unroll 2
        for (int it = 0; it < 8; ++it) {
          int r = 2 + (tid >> 4) + 16 * it;
          int tk = tokbase + r;
          if (r < 128 && tk < SEQ) {
            h16x2 ga[4], va[4];
#pragma unroll
            for (int q = 0; q < 4; ++q) { ga[q] = bg[q]; va[q] = bv[q]; }
#pragma unroll
            for (int j = 0; j < 3; ++j) {
              const u32x4 tg = *(LAS const u32x4*)(smem + (r - 2 + j) * 528 + lg);
              const u32x4 tv = *(LAS const u32x4*)(smem + (r - 2 + j) * 528 + lv);
              const unsigned tgs[4] = {tg.x, tg.y, tg.z, tg.w}, tvs[4] = {tv.x, tv.y, tv.z, tv.w};
#pragma unroll
              for (int q = 0; q < 4; ++q) {
                ga[q] = wg[j][q] * __builtin_bit_cast(h16x2, tgs[q]) + ga[q];
                va[q] = wv[j][q] * __builtin_bit_cast(h16x2, tvs[q]) + va[q];
              }
            }
            u32x4 ov;
            unsigned ow[4];
#pragma unroll
            for (int q = 0; q < 4; ++q) ow[q] = pk2(siluf((float)ga[q].x) * (float)va[q].x, siluf((float)ga[q].y) * (float)va[q].y);
            ov.x = ow[0]; ov.y = ow[1]; ov.z = ow[2]; ov.w = ow[3];
            *(u32x4*)(p.act + slab_idx((long)b * SEQ + tk, gcol, NTOK)) = ov;
          }
        }
      }
    }
  }
}

__device__ __forceinline__ void xbc_conv8(const P& p, int layer, long row, int tb, int ccol, float* o) {
  const bf16_t* wh = p.cwh + (long)layer * 5120 + ccol;
  const u32x4 bb = gld128(wh + 4096);
  h16x2 acc0 = as_h2(bb.x), acc1 = as_h2(bb.y), acc2 = as_h2(bb.z), acc3 = as_h2(bb.w);
#pragma unroll
  for (int j = 0; j < 4; ++j) {
    if (tb - 3 + j >= 0) {
      const u32x4 v = gld128(p.proj + (row - 3 + j) * NP + C_XBC + ccol);
      const u32x4 w = gld128(wh + j * 1024);
      acc0 = as_h2(w.x) * as_h2(v.x) + acc0;
      acc1 = as_h2(w.y) * as_h2(v.y) + acc1;
      acc2 = as_h2(w.z) * as_h2(v.z) + acc2;
      acc3 = as_h2(w.w) * as_h2(v.w) + acc3;
    }
  }
  o[0] = siluf((float)acc0.x); o[1] = siluf((float)acc0.y); o[2] = siluf((float)acc1.x); o[3] = siluf((float)acc1.y);
  o[4] = siluf((float)acc2.x); o[5] = siluf((float)acc2.y); o[6] = siluf((float)acc3.x); o[7] = siluf((float)acc3.y);
}

__device__ __forceinline__ void ssd_dt_scan(const P& p, int layer, long row0, int hd, int lane, ldsp dts, ldsp acs) {
  float dtr = bf2f(p.proj[(row0 + lane) * NP + C_DT + hd]) + p.ssd_dt_bias[layer * 8 + hd];
  float dt = softplusf(dtr);
  float a = -dt * expf(p.ssd_a_log[layer * 8 + hd]);
  float cs = a;
#pragma unroll
  for (int o = 1; o < 64; o <<= 1) {
    float t = __shfl_up(cs, o);
    if (lane >= o) cs += t;
  }
  stsf(dts + lane * 4, dt);
  stsf(acs + lane * 4, cs);
}

__device__ __forceinline__ void ssd1_item(const P& p, int layer, int item, ldsp smem) {
  asm volatile("" : "+s"(layer));
  const int tid = tidx(), lane = tid & 63, w = tid >> 6, i = lane & 15, g = lane >> 4;
  int b = item >> 8, c = (item >> 1) & 127, grp = item & 1;
  long row0 = (long)b * SEQ + c * 64;
  int tb0 = c * 64;
  ldsp Bs = smem, Xs = smem + 17408, dts = smem + 51200, acs = smem + 52224;
  __syncthreads();
  ssd_dt_scan(p, layer, row0, 4 * grp + w, lane, dts + w * 256, acs + w * 256);
  __syncthreads();
#pragma unroll 1
  for (int it = 0; it < 4; ++it) {
    int r = (tid >> 4) + 16 * it, ch = tid & 15;
    float o[8];
    xbc_conv8(p, layer, row0 + r, tb0 + r, 512 + 128 * grp + ch * 8, o);
    st128(Bs + r * 272 + ch * 16, __builtin_bit_cast(u32x4, pack8(o)));
  }
#pragma unroll 2
  for (int it = 0; it < 8; ++it) {
    int r = (tid >> 5) + 8 * it, ch = tid & 31;
    int hh = ch >> 3;
    float o[8];
    xbc_conv8(p, layer, row0 + r, tb0 + r, (4 * grp) * 64 + ch * 8, o);
    float sc = ldsf(dts + hh * 256 + r * 4) * __expf(ldsf(acs + hh * 256 + 63 * 4) - ldsf(acs + hh * 256 + r * 4));
#pragma unroll
    for (int e = 0; e < 8; ++e) o[e] *= sc;
    st128(Xs + r * 528 + ch * 16, __builtin_bit_cast(u32x4, pack8(o)));
  }
  __syncthreads();
  int hd = 4 * grp + w;
  bf16_t* st = p.states + (((long)b * 128 + c) * 8 + hd) * 8192;
#pragma unroll 1
  for (int nh = 0; nh < 2; ++nh) {
    f32x4 acc[4][4];
#pragma unroll
    for (int pf = 0; pf < 4; ++pf)
#pragma unroll
      for (int nf = 0; nf < 4; ++nf) acc[pf][nf] = (f32x4){0.f, 0.f, 0.f, 0.f};
#pragma unroll
    for (int ks = 0; ks < 2; ++ks) {
      bf16x8 af[4], bfr[4];
      int rr = 32 * ks + 8 * g + (i >> 2);
#pragma unroll
      for (int pf = 0; pf < 4; ++pf) {
        ldsp a = Xs + rr * 528 + (64 * w + 16 * pf + 4 * (i & 3)) * 2;
        af[pf] = cat4(ldtr(a), ldtr(a + 4 * 528));
      }
#pragma unroll
      for (int nf = 0; nf < 4; ++nf) {
        ldsp a = Bs + rr * 272 + (16 * (4 * nh + nf) + 4 * (i & 3)) * 2;
        bfr[nf] = cat4(ldtr(a), ldtr(a + 4 * 272));
      }
#pragma unroll
      for (int pf = 0; pf < 4; ++pf)
#pragma unroll
        for (int nf = 0; nf < 4; ++nf) acc[pf][nf] = mfma16(bfr[nf], af[pf], acc[pf][nf]);
    }
#pragma unroll
    for (int pf = 0; pf < 4; ++pf)
#pragma unroll
      for (int nf = 0; nf < 4; ++nf)
      {
        const f32x4 v = acc[pf][nf];
        u32x2 o; o.x = pk2(v[0], v[1]); o.y = pk2(v[2], v[3]);
        *(u32x2*)(st + (16 * pf + i) * 128 + 16 * (4 * nh + nf) + 4 * g) = o;
      }
  }
  if (lane == 0) p.cdec[((long)b * 128 + c) * 8 + hd] = __expf(ldsf(acs + w * 256 + 63 * 4));
}

__device__ __forceinline__ void ssd2_item(const P& p, int item) {
  asm volatile("" : "+s"(item));
  int idx = item * 256 + tidx();
  int bh = idx >> 12, e = idx & 4095;
  int b = bh >> 3, hd = bh & 7;
  unsigned* S = (unsigned*)p.states;
  float h0 = 0.f, h1 = 0.f;
  for (int c0 = 0; c0 < 128; c0 += 16) {
    unsigned v[16]; float dc[16];
#pragma unroll
    for (int u = 0; u < 16; ++u) {
      long cb = ((long)b * 128 + c0 + u) * 8 + hd;
      v[u] = S[cb * 4096 + e];
      dc[u] = p.cdec[cb];
    }
#pragma unroll
    for (int u = 0; u < 16; ++u) {
      long cb = ((long)b * 128 + c0 + u) * 8 + hd;
      S[cb * 4096 + e] = pk2(h0, h1);
      h0 = h0 * dc[u] + bflo(v[u]);
      h1 = h1 * dc[u] + bfhi(v[u]);
    }
  }
}

__device__ __forceinline__ void cmp_gemm2_item(const P& p, int layer, int item) {
  asm volatile("" : "+s"(layer));
  int idx = item * 256 + tidx();
  int kv = idx >> 17, m = (idx >> 6) & 2047, d = idx & 63;
  const float* w2 = (kv ? p.cmp_v_w2 : p.cmp_k_w2) + (long)layer * 128 * 64;
  const bf16_t* hr = p.hid + ((long)kv * 2048 + m) * 128;
  float s = 0.f;
  if ((m & 511) != 511) {
    for (int n8 = 0; n8 < 16; ++n8) {
      float v[8];
      unpack8(gld128(hr + n8 * 8), v);
#pragma unroll
      for (int e = 0; e < 8; ++e) s += v[e] * w2[(n8 * 8 + e) * 64 + d];
    }
  }
  p.kcvc[((long)kv * 2048 + m) * 64 + d] = f2bf(s);
}

__device__ __forceinline__ void shortconv_item(const P& p, int layer, int item) {
  asm volatile("" : "+s"(layer));
  const int tid = tidx();
  const float* cw = p.sc_conv_w + (long)layer * 3 * 256;
  for (int it = 0; it < 8; ++it) {
    int q = it * 256 + tid;
    int r = q >> 5, ch = q & 31;
    long row = (long)item * 64 + r;
    int tb = (int)(row & (SEQ - 1));
    float o[8];
#pragma unroll
    for (int e = 0; e < 8; ++e) o[e] = 0.f;
#pragma unroll
    for (int j = 0; j < 3; ++j) {
      if (tb - 2 + j >= 0) {
        float a[8], bb[8];
        unpack8(gld128(p.proj + (row - 2 + j) * NP + C_SCC + ch * 8), a);
        unpack8(gld128(p.proj + (row - 2 + j) * NP + C_SCH + ch * 8), bb);
#pragma unroll
        for (int e = 0; e < 8; ++e) o[e] += cw[j * 256 + ch * 8 + e] * (a[e] * bb[e]);
      }
    }
    float sb[8];
    unpack8(gld128(p.proj + row * NP + C_SCB + ch * 8), sb);
#pragma unroll
    for (int e = 0; e < 8; ++e) o[e] *= sb[e];
    *(u32x4*)(p.ymix + slab_idx(row, 512 + ch * 8, NTOK)) = __builtin_bit_cast(u32x4, pack8(o));
  }
}

__device__ __forceinline__ void ssd3_item(const P& p, int layer, int item, ldsp smem) {
  asm volatile("" : "+s"(layer));
  const int tid = tidx(), lane = tid & 63, w = tid >> 6, i = lane & 15, g = lane >> 4;
  int b = item >> 7, c = item & 127;
  long row0 = (long)b * SEQ + c * 64;
  int tb0 = c * 64;
  ldsp Cs = smem, Bs = smem + 17408, Xh = smem + 34816, dts = smem + 44032, acs = smem + 45056;
  float ssq = 0.f;
  const int lq = 16 * w + i;
#pragma unroll 1
  for (int grp = 0; grp < 2; ++grp) {
    __syncthreads();
    ssd_dt_scan(p, layer, row0, 4 * grp + w, lane, dts + w * 256, acs + w * 256);
    for (int it = 0; it < 4; ++it) {
      int r = (tid >> 4) + 16 * it, ch = tid & 15;
      float o[8];
      xbc_conv8(p, layer, row0 + r, tb0 + r, 768 + 128 * grp + ch * 8, o);
      st128(Cs + r * 272 + ch * 16, __builtin_bit_cast(u32x4, pack8(o)));
      xbc_conv8(p, layer, row0 + r, tb0 + r, 512 + 128 * grp + ch * 8, o);
      st128(Bs + r * 272 + ch * 16, __builtin_bit_cast(u32x4, pack8(o)));
    }
    __syncthreads();
    bf16x8 cf[4];
#pragma unroll
    for (int ks = 0; ks < 4; ++ks) cf[ks] = ld128(Cs + lq * 272 + (32 * ks + 8 * g) * 2);
    f32x4 sT[4];
#pragma unroll
    for (int sf = 0; sf < 4; ++sf) {
      sT[sf] = (f32x4){0.f, 0.f, 0.f, 0.f};
#pragma unroll
      for (int ks = 0; ks < 4; ++ks) sT[sf] = mfma16(ld128(Bs + (16 * sf + i) * 272 + (32 * ks + 8 * g) * 2), cf[ks], sT[sf]);
    }
#pragma unroll 1
    for (int hh = 0; hh < 4; ++hh) {
      const int hd = 4 * grp + hh;
      __syncthreads();
      {
        const bf16_t* st = p.states + (((long)b * 128 + c) * 8 + hd) * 8192;
        for (int it = 0; it < 4; ++it) {
          int r = (tid >> 4) + 16 * it, ch = tid & 15;
          st128(Bs + r * 272 + ch * 16, gld128(st + r * 128 + ch * 8));
        }
        for (int it = 0; it < 2; ++it) {
          int r = (tid >> 3) + 32 * it, ch = tid & 7;
          float o[8];
          xbc_conv8(p, layer, row0 + r, tb0 + r, hd * 64 + ch * 8, o);
          st128(Xh + r * 144 + ch * 16, __builtin_bit_cast(u32x4, pack8(o)));
        }
      }
      __syncthreads();
      f32x4 acc[4];
#pragma unroll
      for (int pf = 0; pf < 4; ++pf) {
        acc[pf] = (f32x4){0.f, 0.f, 0.f, 0.f};
#pragma unroll
        for (int ks = 0; ks < 4; ++ks) acc[pf] = mfma16(ld128(Bs + (16 * pf + i) * 272 + (32 * ks + 8 * g) * 2), cf[ks], acc[pf]);
      }
      const float al = ldsf(acs + hh * 256 + lq * 4);
      const float el = __expf(al);
#pragma unroll
      for (int pf = 0; pf < 4; ++pf) acc[pf] *= el;
      const float Dh = p.ssd_d[layer * 8 + hd];
      f32x4 pt[4];
#pragma unroll
      for (int sf = 0; sf < 4; ++sf)
#pragma unroll
        for (int r = 0; r < 4; ++r) {
          int s = 16 * sf + 4 * g + r;
          float v = 0.f;
          if (s <= lq) v = sT[sf][r] * ldsf(dts + hh * 256 + s * 4) * __expf(al - ldsf(acs + hh * 256 + s * 4));
          if (s == lq) v += Dh;
          pt[sf][r] = v;
        }
#pragma unroll
      for (int ks = 0; ks < 2; ++ks) {
        bf16x8 pb = pack44(pt[2 * ks], pt[2 * ks + 1]);
#pragma unroll
        for (int pf = 0; pf < 4; ++pf) {
          ldsp a = Xh + (32 * ks + 4 * g + (i >> 2)) * 144 + (16 * pf + 4 * (i & 3)) * 2;
          acc[pf] = mfma16(cat4(ldtr(a), ldtr(a + 16 * 144)), pb, acc[pf]);
        }
      }
#pragma unroll
      for (int pf = 0; pf < 4; ++pf) {
        int col = hd * 64 + 16 * pf + 4 * g;
        u32x2 zz = *(const u32x2*)(p.proj + (row0 + lq) * NP + C_Z + col);
        float z0 = bflo(zz.x), z1 = bfhi(zz.x), z2 = bflo(zz.y), z3 = bfhi(zz.y);
        f32x4 y;
        y[0] = acc[pf][0] * siluf(z0); y[1] = acc[pf][1] * siluf(z1);
        y[2] = acc[pf][2] * siluf(z2); y[3] = acc[pf][3] * siluf(z3);
        ssq += y[0] * y[0] + y[1] * y[1] + y[2] * y[2] + y[3] * y[3];
        { u32x2 yp; yp.x = pk2(y[0], y[1]); yp.y = pk2(y[2], y[3]); *(u32x2*)(p.ymix + slab_idx(row0 + lq, col, NTOK)) = yp; }
      }
    }
  }
  ssq += __shfl_xor(ssq, 16);
  ssq += __shfl_xor(ssq, 32);
  const float rstd = rsqrtf(ssq * (1.f / 512.f) + 1e-6f);
  const float* nw = p.ssd_norm_w + layer * 512;
#pragma unroll 1
  for (int q = 0; q < 32; ++q) {
    int col = (q >> 2) * 64 + 16 * (q & 3) + 4 * g;
    float4 w4 = *(const float4*)(nw + col);
    u32x2* yp_ = (u32x2*)(p.ymix + slab_idx(row0 + lq, col, NTOK));
    u32x2 yp = *yp_;
    u32x2 o;
    o.x = pk2(bflo(yp.x) * rstd * w4.x, bfhi(yp.x) * rstd * w4.y);
    o.y = pk2(bflo(yp.y) * rstd * w4.z, bfhi(yp.y) * rstd * w4.w);
    *yp_ = o;
  }
}

template <int NH>
__device__ __forceinline__ void qk_tile(f32x4 (&s)[4][NH], ldsp Ks, const bf16x8 (&qf)[NH][2], int i, int g) {
#pragma unroll
  for (int kf = 0; kf < 4; ++kf)
#pragma unroll
    for (int h = 0; h < NH; ++h) s[kf][h] = (f32x4){0.f, 0.f, 0.f, 0.f};
  __builtin_amdgcn_s_setprio(1);
#pragma unroll
  for (int ks = 0; ks < 2; ++ks)
#pragma unroll
    for (int kf = 0; kf < 4; ++kf) {
      bf16x8 a = ld128(Ks + (16 * kf + i) * 144 + (32 * ks + 8 * g) * 2);
#pragma unroll
      for (int h = 0; h < NH; ++h) s[kf][h] = mfma16(a, qf[h][ks], s[kf][h]);
    }
  __builtin_amdgcn_s_setprio(0);
}
__device__ __forceinline__ void pv_tile(f32x4 (&o)[4][2], ldsp Vs, const f32x4 (&s)[4][2], int i, int g) {
  __builtin_amdgcn_s_setprio(1);
#pragma unroll
  for (int ks = 0; ks < 2; ++ks) {
    bf16x8 pb[2];
#pragma unroll
    for (int h = 0; h < 2; ++h) pb[h] = pack44_rtz(s[2 * ks][h], s[2 * ks + 1][h]);
#pragma unroll
    for (int df = 0; df < 4; ++df) {
      ldsp a = Vs + (32 * ks + 4 * g + (i >> 2)) * 144 + (16 * df + 4 * (i & 3)) * 2;
      bf16x8 av = cat4(ldtr(a), ldtr(a + 16 * 144));
#pragma unroll
      for (int h = 0; h < 2; ++h) o[df][h] = mfma16(av, pb[h], o[df][h]);
    }
  }
  __builtin_amdgcn_s_setprio(0);
}
__device__ __forceinline__ void stage64_ld(u32x4 (&r)[2], const bf16_t* src, long stride) {
  const int tid = tidx();
#pragma unroll
  for (int it = 0; it < 2; ++it) r[it] = gld128(src + (long)((tid >> 3) + 32 * it) * stride + (tid & 7) * 8);
}
__device__ __forceinline__ void stage64_st(const u32x4 (&r)[2], ldsp dst) {
  const int tid = tidx();
#pragma unroll
  for (int it = 0; it < 2; ++it) st128(dst + ((tid >> 3) + 32 * it) * 144 + (tid & 7) * 16, r[it]);
}

__device__ __forceinline__ void osm_update(f32x4 (&s)[4][2], const bool (&vm)[4][4], float (&m)[2], float (&l)[2], f32x4 (&o)[4][2]) {
#pragma unroll
  for (int h = 0; h < 2; ++h) {
    float tmax = -1e30f;
#pragma unroll
    for (int kf = 0; kf < 4; ++kf)
#pragma unroll
      for (int r = 0; r < 4; ++r) {
        float v = vm[kf][r] ? s[kf][h][r] : -1e30f;
        tmax = fmaxf(tmax, v);
      }
    tmax = fmaxf(tmax, __shfl_xor(tmax, 16));
    tmax = fmaxf(tmax, __shfl_xor(tmax, 32));
    float mnew = fmaxf(m[h], tmax);
    float alpha = ex2(m[h] - mnew);
    m[h] = mnew;
    float ps = 0.f;
#pragma unroll
    for (int kf = 0; kf < 4; ++kf)
#pragma unroll
      for (int r = 0; r < 4; ++r) {
        float pv = vm[kf][r] ? ex2(s[kf][h][r] - mnew) : 0.f;
        s[kf][h][r] = pv;
        ps += pv;
      }
    l[h] = l[h] * alpha + ps;
#pragma unroll
    for (int df = 0; df < 4; ++df) o[df][h] *= alpha;
  }
}

template <bool LANEMASK>
__device__ __forceinline__ void osm_update_full(f32x4 (&s)[4][2], bool lv, float (&m)[2], float (&l)[2], f32x4 (&o)[4][2]) {
#pragma unroll
  for (int h = 0; h < 2; ++h) {
    float tmax = s[0][h][0];
#pragma unroll
    for (int kf = 0; kf < 4; ++kf)
#pragma unroll
      for (int r = 0; r < 4; ++r) tmax = fmaxf(tmax, s[kf][h][r]);
    if (LANEMASK) tmax = lv ? tmax : -1e30f;
    tmax = fmaxf(tmax, __shfl_xor(tmax, 16));
    tmax = fmaxf(tmax, __shfl_xor(tmax, 32));
    float mnew = fmaxf(m[h], tmax);
    float alpha = ex2(m[h] - mnew);
    m[h] = mnew;
    float ps = 0.f;
#pragma unroll
    for (int kf = 0; kf < 4; ++kf)
#pragma unroll
      for (int r = 0; r < 4; ++r) {
        float pv = ex2(s[kf][h][r] - mnew);
        if (LANEMASK) pv = lv ? pv : 0.f;
        s[kf][h][r] = pv;
        ps += pv;
      }
    l[h] = l[h] * alpha + ps;
#pragma unroll
    for (int df = 0; df < 4; ++df) o[df][h] *= alpha;
  }
}

__device__ __forceinline__ void nsa_item(const P& p, int layer, int item, ldsp smem) {
  asm volatile("" : "+s"(layer));
  const int tid = tidx(), lane = tid & 63, w = tid >> 6, i = lane & 15, g = lane >> 4;
  const int sub = item & 7, b = sub >> 1, hp = sub & 1;
  const int rnk = (item & 511) >> 3;
  const int qt = item < 512 ? 127 - rnk : rnk;
  const int t0 = qt * 64;
  const int tl = t0 + 16 * w + i;
  const long rowl = (long)b * SEQ + tl;
  const long rowb = (long)b * SEQ;
  ldsp Ks = smem, Vs = smem + 9216, imp = smem + 18432, selm = smem + 52224, uni = smem + 53248, lst = smem + 53280;
  const bf16_t* kc = p.kcvc + (long)b * 512 * 64;
  const bf16_t* vc = p.kcvc + (long)2048 * 64 + (long)b * 512 * 64;
  __syncthreads();
  for (int e = tid; e < 64 * 132; e += 256) stsf(imp + e * 4, 0.f);
  const int nhi = (t0 + 32) >> 4;
  const int ncmp = (nhi > 510 ? 510 : nhi) / 64 + 1;
  float m4[4], inv4[4];
  {
    bf16x8 qf[4][2];
#pragma unroll
    for (int h = 0; h < 4; ++h)
#pragma unroll
      for (int ks = 0; ks < 2; ++ks)
        qf[h][ks] = __builtin_bit_cast(bf16x8, gld128(p.proj + rowl * NP + C_Q + h * 64 + 32 * ks + 8 * g));
    float l4[4];
#pragma unroll
    for (int h = 0; h < 4; ++h) { m4[h] = -1e30f; l4[h] = 0.f; }
    {
      u32x4 kr[2];
      stage64_ld(kr, kc, 64);
      for (int kt = 0; kt < ncmp; ++kt) {
        __syncthreads();
        stage64_st(kr, Ks);
        __syncthreads();
        if (kt + 1 < ncmp) stage64_ld(kr, kc + (long)(kt + 1) * 64 * 64, 64);
        f32x4 s[4][4];
        qk_tile<4>(s, Ks, qf, i, g);
        const bool cfull = ((kt * 64 + 63) * 16 + 31 <= t0) && (kt * 64 + 63 < 511);
        if (cfull) {
#pragma unroll
          for (int h = 0; h < 4; ++h) {
            float tmax = s[0][h][0];
#pragma unroll
            for (int kf = 0; kf < 4; ++kf)
#pragma unroll
              for (int r = 0; r < 4; ++r) tmax = fmaxf(tmax, s[kf][h][r]);
            tmax = fmaxf(tmax, __shfl_xor(tmax, 16));
            tmax = fmaxf(tmax, __shfl_xor(tmax, 32));
            float mnew = fmaxf(m4[h], tmax);
            float ps = 0.f;
#pragma unroll
            for (int kf = 0; kf < 4; ++kf)
#pragma unroll
              for (int r = 0; r < 4; ++r) ps += ex2(s[kf][h][r] - mnew);
            l4[h] = l4[h] * ex2(m4[h] - mnew) + ps;
            m4[h] = mnew;
          }
        } else {
#pragma unroll
        for (int h = 0; h < 4; ++h) {
          float tmax = -1e30f;
#pragma unroll
          for (int kf = 0; kf < 4; ++kf)
#pragma unroll
            for (int r = 0; r < 4; ++r) {
              int key = kt * 64 + 16 * kf + 4 * g + r;
              bool ok = (key * 16 + 31 <= tl) && key < 511;
              float v = ok ? s[kf][h][r] : -1e30f;
              s[kf][h][r] = v;
              tmax = fmaxf(tmax, v);
            }
          tmax = fmaxf(tmax, __shfl_xor(tmax, 16));
          tmax = fmaxf(tmax, __shfl_xor(tmax, 32));
          float mnew = fmaxf(m4[h], tmax);
          float ps = 0.f;
#pragma unroll
          for (int kf = 0; kf < 4; ++kf)
#pragma unroll
            for (int r = 0; r < 4; ++r) ps += (s[kf][h][r] > -1e29f) ? ex2(s[kf][h][r] - mnew) : 0.f;
          l4[h] = l4[h] * ex2(m4[h] - mnew) + ps;
          m4[h] = mnew;
        }
        }
      }
    }
#pragma unroll
    for (int h = 0; h < 4; ++h) {
      float lt = l4[h];
      lt += __shfl_xor(lt, 16);
      lt += __shfl_xor(lt, 32);
      inv4[h] = 1.f / fmaxf(lt, 1e-20f);
    }
    {
      u32x4 kr[2];
      stage64_ld(kr, kc, 64);
      for (int kt = 0; kt < ncmp; ++kt) {
        __syncthreads();
        stage64_st(kr, Ks);
        __syncthreads();
        if (kt + 1 < ncmp) stage64_ld(kr, kc + (long)(kt + 1) * 64 * 64, 64);
        f32x4 s[4][4];
        qk_tile<4>(s, Ks, qf, i, g);
        const bool cfull2 = ((kt * 64 + 63) * 16 + 31 <= t0) && (kt * 64 + 63 < 511);
        float mainv[4], spill[4];
#pragma unroll
        for (int kf = 0; kf < 4; ++kf) {
          mainv[kf] = 0.f; spill[kf] = 0.f;
#pragma unroll
          for (int r = 0; r < 4; ++r) {
            float pr = 0.f;
            if (cfull2) {
#pragma unroll
              for (int h = 0; h < 4; ++h) pr += ex2(s[kf][h][r] - m4[h]) * inv4[h];
            } else {
              int key = kt * 64 + 16 * kf + 4 * g + r;
              bool ok = (key * 16 + 31 <= tl) && key < 511;
#pragma unroll
              for (int h = 0; h < 4; ++h) pr += ok ? ex2(s[kf][h][r] - m4[h]) * inv4[h] : 0.f;
            }
            mainv[kf] += pr;
            if (r == 3) spill[kf] = pr;
          }
        }
        ldsp ir = imp + (16 * w + i) * 528;
#pragma unroll
        for (int kf = 0; kf < 4; ++kf) {
          int blk = 16 * kt + 4 * kf + g;
          stsf(ir + blk * 4, ldsf(ir + blk * 4) + mainv[kf]);
        }
#pragma unroll
        for (int kf = 0; kf < 4; ++kf) {
          int blk = 16 * kt + 4 * kf + g + 1;
          stsf(ir + blk * 4, ldsf(ir + blk * 4) + spill[kf]);
        }
      }
    }
  }
  __syncthreads();
  {
    int tok = tid >> 2, sb = tid & 3;
    unsigned mask = 0;
    const int cur = qt;
    ldsp ir = imp + tok * 528;
    if (cur < 16) {
      for (int j = 32 * sb; j < 32 * sb + 32; ++j)
        if (j <= cur) mask |= 1u << (j & 31);
    } else {
      float v[32];
#pragma unroll
      for (int q4 = 0; q4 < 8; ++q4) {
        f32x4 vv = *(LAS const f32x4*)(ir + (32 * sb + 4 * q4) * 4);
#pragma unroll
        for (int e = 0; e < 4; ++e) {
          int j = 32 * sb + 4 * q4 + e;
          v[4 * q4 + e] = (j >= 1 && j <= cur - 2) ? vv[e] : -INFINITY;
          if (j == 0 || (j > cur - 2 && j <= cur)) mask |= 1u << (j & 31);
        }
      }
#pragma unroll 1
      for (int round = 0; round < 13; ++round) {
        float bv = -INFINITY; int be = 0;
#pragma unroll
        for (int e = 0; e < 32; ++e) { bool gt_ = v[e] > bv; bv = gt_ ? v[e] : bv; be = gt_ ? e : be; }
        int bj = 32 * sb + be;
#pragma unroll
        for (int o = 1; o <= 2; o <<= 1) {
          float ov = __shfl_xor(bv, o); int oj = __shfl_xor(bj, o);
          bool take = (ov > bv) || (ov == bv && oj < bj);
          bv = take ? ov : bv; bj = take ? oj : bj;
        }
        if ((bj >> 5) == sb) {
          int e0 = bj & 31;
          mask |= 1u << e0;
#pragma unroll
          for (int e = 0; e < 32; ++e) v[e] = (e == e0) ? -INFINITY : v[e];
        }
      }
    }
    stsu(selm + (tok * 4 + sb) * 4, mask);
  }
  __syncthreads();
  if (w == 0) {
    unsigned a0 = ldsu(selm + (lane * 4 + 0) * 4), a1 = ldsu(selm + (lane * 4 + 1) * 4), a2 = ldsu(selm + (lane * 4 + 2) * 4), a3 = ldsu(selm + (lane * 4 + 3) * 4);
#pragma unroll
    for (int o = 32; o >= 1; o >>= 1) { a0 |= __shfl_xor(a0, o); a1 |= __shfl_xor(a1, o); a2 |= __shfl_xor(a2, o); a3 |= __shfl_xor(a3, o); }
    if (lane == 0) { stsu(uni, a0); stsu(uni + 4, a1); stsu(uni + 8, a2); stsu(uni + 12, a3); }
  }
  __syncthreads();
  if (tid < 128) {
    const unsigned u0 = ldsu(uni), u1 = ldsu(uni + 4), u2 = ldsu(uni + 8), u3 = ldsu(uni + 12);
    const int wd = tid >> 5, bp = tid & 31;
    const unsigned uw = wd == 0 ? u0 : (wd == 1 ? u1 : (wd == 2 ? u2 : u3));
    const int pos = (wd > 0 ? __popc(u0) : 0) + (wd > 1 ? __popc(u1) : 0) + (wd > 2 ? __popc(u2) : 0) + __popc(uw & ((1u << bp) - 1u));
    if ((uw >> bp) & 1u) stsu(lst + 4 + pos * 4, (unsigned)tid);
    if (tid == 0) stsu(lst, (unsigned)(__popc(u0) + __popc(u1) + __popc(u2) + __popc(u3)));
  }
  __syncthreads();
  const int nsel = __builtin_amdgcn_readfirstlane((int)ldsu(lst));
  unsigned mysel[4];
#pragma unroll
  for (int q = 0; q < 4; ++q) mysel[q] = ldsu(selm + ((16 * w + i) * 4 + q) * 4);
  {
    bf16x8 qf[2][2];
    float gt[2][3];
#pragma unroll
    for (int h = 0; h < 2; ++h) {
#pragma unroll
      for (int ks = 0; ks < 2; ++ks)
        qf[h][ks] = __builtin_bit_cast(bf16x8, gld128(p.proj + rowl * NP + C_Q + (2 * hp + h) * 64 + 32 * ks + 8 * g));
#pragma unroll
      for (int br = 0; br < 3; ++br) gt[h][br] = sigmf(bf2f(p.proj[rowl * NP + C_G + 3 * (2 * hp + h) + br]));
    }
    float mh[2], ih[2];
    mh[0] = hp ? m4[2] : m4[0]; mh[1] = hp ? m4[3] : m4[1];
    ih[0] = hp ? inv4[2] : inv4[0]; ih[1] = hp ? inv4[3] : inv4[1];
    f32x4 out[4][2];
#pragma unroll
    for (int df = 0; df < 4; ++df)
#pragma unroll
      for (int h = 0; h < 2; ++h) out[df][h] = (f32x4){0.f, 0.f, 0.f, 0.f};
    {
      u32x4 kr[2], vr[2];
      stage64_ld(kr, kc, 64);
      stage64_ld(vr, vc, 64);
      for (int kt = 0; kt < ncmp; ++kt) {
        __syncthreads();
        stage64_st(kr, Ks);
        stage64_st(vr, Vs);
        __syncthreads();
        if (kt + 1 < ncmp) {
          stage64_ld(kr, kc + (long)(kt + 1) * 64 * 64, 64);
          stage64_ld(vr, vc + (long)(kt + 1) * 64 * 64, 64);
        }
        f32x4 s[4][2];
        qk_tile<2>(s, Ks, qf, i, g);
        const bool cfull3 = ((kt * 64 + 63) * 16 + 31 <= t0) && (kt * 64 + 63 < 511);
        const float cg0 = ih[0] * gt[0][0], cg1 = ih[1] * gt[1][0];
#pragma unroll
        for (int kf = 0; kf < 4; ++kf)
#pragma unroll
          for (int r = 0; r < 4; ++r) {
            if (cfull3) {
              s[kf][0][r] = ex2(s[kf][0][r] - mh[0]) * cg0;
              s[kf][1][r] = ex2(s[kf][1][r] - mh[1]) * cg1;
            } else {
              int key = kt * 64 + 16 * kf + 4 * g + r;
              bool ok = (key * 16 + 31 <= tl) && key < 511;
              s[kf][0][r] = ok ? ex2(s[kf][0][r] - mh[0]) * cg0 : 0.f;
              s[kf][1][r] = ok ? ex2(s[kf][1][r] - mh[1]) * cg1 : 0.f;
            }
          }
        pv_tile(out, Vs, s, i, g);
      }
    }
#pragma unroll 1
    for (int br = 1; br < 3; ++br) {
      f32x4 o[4][2];
      float m[2], l[2];
#pragma unroll
      for (int h = 0; h < 2; ++h) {
        m[h] = -1e30f; l[h] = 0.f;
#pragma unroll
        for (int df = 0; df < 4; ++df) o[df][h] = (f32x4){0.f, 0.f, 0.f, 0.f};
      }
      const int jw0 = t0 >= 512 ? 0 : (512 - t0) >> 6;
      const int ntile = br == 1 ? nsel : 9 - jw0;
      const int kcol = br == 1 ? C_KS : C_KW, vcol = br == 1 ? C_VS : C_VW;
      auto tile_tok = [&](int idx) -> int {
        if (br == 1) return 64 * __builtin_amdgcn_readfirstlane((int)ldsu(lst + 4 + idx * 4));
        return t0 - 512 + 64 * (jw0 + idx);
      };
      u32x4 kr[2], vr[2];
      int ktn = tile_tok(0);
      stage64_ld(kr, p.proj + (rowb + ktn) * NP + kcol, NP);
      stage64_ld(vr, p.proj + (rowb + ktn) * NP + vcol, NP);
      for (int idx = 0; idx < ntile; ++idx) {
        const int kt0 = ktn;
        __syncthreads();
        stage64_st(kr, Ks);
        stage64_st(vr, Vs);
        __syncthreads();
        if (idx + 1 < ntile) {
          ktn = tile_tok(idx + 1);
          stage64_ld(kr, p.proj + (rowb + ktn) * NP + kcol, NP);
          stage64_ld(vr, p.proj + (rowb + ktn) * NP + vcol, NP);
        }
        bool selbit = true;
        if (br == 1) {
          int j = kt0 >> 6;
          unsigned mw = j < 32 ? mysel[0] : (j < 64 ? mysel[1] : (j < 96 ? mysel[2] : mysel[3]));
          selbit = (mw >> (j & 31)) & 1u;
        }
        if (br == 1 && !__any(selbit)) continue;
        f32x4 s[4][2];
        qk_tile<2>(s, Ks, qf, i, g);
        const bool full = (kt0 + 63 <= t0) && (br == 1 || kt0 >= t0 - 448);
        if (full) {
          if (br == 1) osm_update_full<true>(s, selbit, m, l, o);
          else osm_update_full<false>(s, true, m, l, o);
        } else {
          bool vm[4][4];
#pragma unroll
          for (int kf = 0; kf < 4; ++kf)
#pragma unroll
            for (int r = 0; r < 4; ++r) {
              int ktok = kt0 + 16 * kf + 4 * g + r;
              vm[kf][r] = br == 1 ? (selbit && ktok <= tl) : (ktok <= tl && ktok > tl - 512);
            }
          osm_update(s, vm, m, l, o);
        }
        pv_tile(o, Vs, s, i, g);
      }
#pragma unroll
      for (int h = 0; h < 2; ++h) {
        float lt = l[h];
        lt += __shfl_xor(lt, 16);
        lt += __shfl_xor(lt, 32);
        float cc = (br == 1 ? gt[h][1] : gt[h][2]) / fmaxf(lt, 1e-20f);
#pragma unroll
        for (int df = 0; df < 4; ++df) out[df][h] += o[df][h] * cc;
      }
    }
#pragma unroll
    for (int h = 0; h < 2; ++h)
#pragma unroll
      for (int df = 0; df < 4; ++df) {
        u32x2 ov;
        ov.x = pk2(out[df][h][0], out[df][h][1]);
        ov.y = pk2(out[df][h][2], out[df][h][3]);
        *(u32x2*)(p.ymix + slab_idx(rowl, 768 + (2 * hp + h) * 64 + 16 * df + 4 * g, NTOK)) = ov;
      }
  }
}

#define XB_TMO      128
#define XB_XCNT(j)  (256  + 64 * (j))
#define XB_XSUB(j)  (1280 + 64 * (j))
#define XB_XGEN(j)  (2304 + 64 * (j))
#define XB_TOP      3328
#define XB_TOPGEN   3392
#define XCD_BAR_WORDS 3456
#define XB_SPIN_CAP (1u << 22)
__device__ __forceinline__ unsigned xb_ld(unsigned* p) { return __hip_atomic_load(p, __ATOMIC_RELAXED, __HIP_MEMORY_SCOPE_AGENT); }
__device__ __forceinline__ unsigned xb_add(unsigned* p, unsigned v) { return __hip_atomic_fetch_add(p, v, __ATOMIC_RELAXED, __HIP_MEMORY_SCOPE_AGENT); }
__device__ __forceinline__ unsigned xb_xcc_id() { return (unsigned)__builtin_amdgcn_s_getreg((3 << 11) | 20) & 0xFu; }
#define XB_SPIN(cond, bar) do { unsigned _sp = 0; while (cond) { __builtin_amdgcn_s_sleep(1); \
    if ((++_sp & 255u) == 0u) { if (xb_ld(&(bar)[XB_TMO])) break; if (_sp > XB_SPIN_CAP) { atomicAdd(&(bar)[XB_TMO], 1u); break; } } } } while (0)
struct XcdBarrier { unsigned* bar; unsigned x; volatile LAS unsigned* st; };
__device__ __forceinline__ XcdBarrier xcd_barrier_post(unsigned* bar, volatile LAS unsigned* st) {
  XcdBarrier b; b.bar = bar; b.x = xb_xcc_id(); b.st = st;
  if (threadIdx.x == 0) (void)xb_add(&bar[XB_XCNT(b.x)], 1u);
  return b;
}
__device__ __forceinline__ void xcd_barrier_complete(unsigned* bar, unsigned x, unsigned& nloc, unsigned& nx) {
  const unsigned G = gridDim.x * gridDim.y * gridDim.z;
  unsigned sum, cnt, mine, sp = 0u;
  for (;;) {
    sum = 0u; cnt = 0u; mine = 0u;
#pragma unroll
    for (unsigned j = 0; j < 16; ++j) { const unsigned c = xb_ld(&bar[XB_XCNT(j)]); sum += c; cnt += (c > 0u) ? 1u : 0u; mine = (j == x) ? c : mine; }
    if (sum == G) break;
    __builtin_amdgcn_s_sleep(1);
    if ((++sp & 255u) == 0u) { if (xb_ld(&bar[XB_TMO])) break; if (sp > XB_SPIN_CAP) { atomicAdd(&bar[XB_TMO], 1u); break; } }
  }
  nloc = mine > 0u ? mine : 1u; nx = cnt > 0u ? cnt : 1u;
}
__device__ __forceinline__ void xcd_barrier(const XcdBarrier& b) {
  asm volatile("s_waitcnt vmcnt(0)" ::: "memory");
  __syncthreads();
  if (threadIdx.x == 0) {
    unsigned* bar = b.bar;
    __builtin_amdgcn_s_waitcnt(0);
    unsigned nloc = b.st[0], nx = b.st[1];
    if (nloc == 0u) { xcd_barrier_complete(bar, b.x, nloc, nx); b.st[0] = nloc; b.st[1] = nx; }
    const unsigned old = xb_add(&bar[XB_XSUB(b.x)], 1u);
    const unsigned gen = old / nloc;
    if (old + 1u == (gen + 1u) * nloc) {
      __builtin_amdgcn_fence(__ATOMIC_RELEASE, "agent");
      asm volatile("s_waitcnt vmcnt(0)" ::: "memory");
      const unsigned og = xb_add(&bar[XB_TOP], 1u);
      const unsigned tg = og / nx;
      if (og + 1u == (tg + 1u) * nx) xb_add(&bar[XB_TOPGEN], 1u);
      else XB_SPIN(xb_ld(&bar[XB_TOPGEN]) == tg, bar);
      __builtin_amdgcn_fence(__ATOMIC_ACQUIRE, "agent");
      xb_add(&bar[XB_XGEN(b.x)], 1u);
      asm volatile("s_waitcnt vmcnt(0)" ::: "memory");
    } else {
      XB_SPIN(xb_ld(&bar[XB_XGEN(b.x)]) == gen, bar);
      __builtin_amdgcn_fence(__ATOMIC_ACQUIRE, "agent");
      asm volatile("s_waitcnt vmcnt(0)" ::: "memory");
    }
  }
  __syncthreads();
}

enum { PH_CONV = 0, PH_INPROJ, PH_MIX1, PH_MIX2, PH_MIX3, PH_OUTPROJ, PH_UP, PH_DOWN, PH_FINAL };

__device__ __forceinline__ void run_phase(const P& p, int ph, int layer, ldsp smem) {
  switch (ph) {
    case PH_CONV: ph_convert(p, smem); ph_prepass(p); break;
    case PH_INPROJ: ph_inproj(p, layer, smem); break;
    case PH_MIX1:
      if (gridDim.x > 64) {
        if (blockIdx.x < 32) cmp_gemm1_tile(p, layer, blockIdx.x, smem);
        else for (int it = blockIdx.x - 32; it < 1024; it += gridDim.x - 32) ssd1_item(p, layer, it, smem);
      } else {
        for (int it = blockIdx.x; it < 32; it += gridDim.x) cmp_gemm1_tile(p, layer, it, smem);
        for (int it = blockIdx.x; it < 1024; it += gridDim.x) ssd1_item(p, layer, it, smem);
      }
      for (int it = blockIdx.x; it < 512; it += gridDim.x) shortconv_item(p, layer, it);
      break;
    case PH_MIX2:
      for (int it = blockIdx.x; it < 512; it += gridDim.x) ssd2_item(p, it);
      for (int it = blockIdx.x; it < 1024; it += gridDim.x) cmp_gemm2_item(p, layer, it);
      break;
    case PH_MIX3:
      for (int it = blockIdx.x; it < 1024; it += gridDim.x) nsa_item(p, layer, it, smem);
      for (int it = blockIdx.x; it < 512; it += gridDim.x) ssd3_item(p, layer, it, smem);
      break;
    case PH_OUTPROJ: ph_resgemm(p.ymix, DM, p.WoutT + (long)layer * DM * DM, p.h, p.ssqp, smem); break;
    case PH_UP: ph_ffn_up(p, layer, smem); break;
    case PH_DOWN: ph_resgemm(p.act, DFF, p.WdownT + (long)layer * DM * DFF, p.h, p.ssqp, smem); break;
    case PH_FINAL: ph_final(p); break;
  }
}

#if SINGLE_LAUNCH
__global__ void __launch_bounds__(256, 2) k_all(P p) {
  extern __shared__ __attribute__((aligned(16))) unsigned char lds_raw[];
  ldsp smem = (ldsp)lds_raw;
  cg::grid_group grid = cg::this_grid();
  volatile LAS unsigned* st = (volatile LAS unsigned*)(smem + LDS_MAIN);
  if (threadIdx.x < 4) st[threadIdx.x] = 0u;
  __syncthreads();
  XcdBarrier xb = xcd_barrier_post(p.bar, st);
  constexpr int NSTEP = 2 + NLAYER * 7;
  for (int step = 0; step < NSTEP; ++step) {
    int ph, layer;
    if (step == 0) { ph = PH_CONV; layer = 0; }
    else if (step == NSTEP - 1) { ph = PH_FINAL; layer = 0; }
    else { layer = (step - 1) / 7; ph = PH_INPROJ + (step - 1) % 7; }
    const int reps = (ph == REP_PH) ? 2 : 1;
    for (int r = 0; r < reps; ++r) run_phase(p, ph, layer, smem);
    if (step == 0) grid.sync();
    else if (step + 1 < NSTEP) xcd_barrier(xb);
  }
}
#define KMAIN k_all
#else
__global__ void __launch_bounds__(256, 2) k_phase(P p, int ph, int layer) {
  extern __shared__ __attribute__((aligned(16))) unsigned char lds_raw[];
  run_phase(p, ph, layer, (ldsp)lds_raw);
}
#define KMAIN k_phase
#endif

extern "C" void kernel_launch(void* const* d_in, const int* in_sizes, int n_in, void* d_out, int out_size, void* d_ws,
                              size_t ws_size, hipStream_t stream) {
  static int grid_blocks = 0;
  if (!grid_blocks) {
    int dev = 0, cus = 0, per_cu = 0;
    (void)hipGetDevice(&dev);
    (void)hipDeviceGetAttribute(&cus, hipDeviceAttributeMultiprocessorCount, dev);
    (void)hipFuncSetAttribute((const void*)KMAIN, hipFuncAttributeMaxDynamicSharedMemorySize, LDS_BYTES);
    (void)hipOccupancyMaxActiveBlocksPerMultiprocessor(&per_cu, (const void*)KMAIN, 256, LDS_BYTES);
    if (per_cu < 1) per_cu = 1;
    if (per_cu > 2) per_cu = 2;
    grid_blocks = cus * per_cu;
  }
  P p{};
  const float** pin = (const float**)&p;
  for (int q = 0; q < 23; ++q) pin[q] = (const float*)d_in[q];
  p.out = (float*)d_out;
  unsigned char* ws = (unsigned char*)d_ws;
  size_t off = 0;
  auto take = [&](size_t bytes) { unsigned char* r = ws + off; off += (bytes + 255) & ~(size_t)255; return r; };
  p.WinT = (bf16_t*)take((size_t)NLAYER * NP * DM * 2);
  p.WoutT = (bf16_t*)take((size_t)NLAYER * DM * DM * 2);
  p.WupT = (bf16_t*)take((size_t)NLAYER * 5632 * DM * 2);
  p.WdownT = (bf16_t*)take((size_t)NLAYER * DM * DFF * 2);
  p.W1T = (bf16_t*)take((size_t)NLAYER * 2 * 128 * 2048 * 2);
  p.zeros = (bf16_t*)take(4096);
  p.cwh = (bf16_t*)take((size_t)NLAYER * 5 * 1024 * 2);
  p.c1 = (float*)take(NLAYER * 2 * 128 * 4);
  p.rope = (float*)take((size_t)SEQ * 64 * 4);
  p.cdec = (float*)take(4 * 128 * 8 * 4);
  p.bar = (unsigned*)take(XCD_BAR_WORDS * 4);
  p.ssqp = (float*)take((size_t)NTOK * 8 * 4);
  p.hid = (bf16_t*)take((size_t)2 * 2048 * 128 * 2);
  p.kcvc = (bf16_t*)take((size_t)2 * 2048 * 64 * 2);
  p.h = (bf16_t*)take((size_t)NTOK * DM * 2);
  p.states = (bf16_t*)take((size_t)NTOK * DM * 2);
  p.proj = (bf16_t*)take((size_t)NTOK * NP * 2);
  p.act = p.proj;
  p.ymix = (bf16_t*)take((size_t)NTOK * DM * 2);
  if (off > ws_size) { fprintf(stderr, "workspace too small: need %zu have %zu\n", off, ws_size); return; }
#if SINGLE_LAUNCH
  (void)hipMemsetAsync(p.bar, 0, XCD_BAR_WORDS * 4, stream);
  void* args[] = {&p};
  hipError_t e = hipLaunchCooperativeKernel((const void*)k_all, dim3(grid_blocks), dim3(256), args, LDS_BYTES, stream);
  if (e != hipSuccess) fprintf(stderr, "cooperative launch failed: %s (grid %d)\n", hipGetErrorString(e), grid_blocks);
#else
  k_phase<<<grid_blocks, 256, LDS_BYTES, stream>>>(p, PH_CONV, 0);
  for (int layer = 0; layer < NLAYER; ++layer)
    for (int ph = PH_INPROJ; ph <= PH_DOWN; ++ph) k_phase<<<grid_blocks, 256, LDS_BYTES, stream>>>(p, ph, layer);
  k_phase<<<grid_blocks, 256, LDS_BYTES, stream>>>(p, PH_FINAL, 0);
#endif
}
```
